# Optimizing an MI355X kernel written in HIP

```python
import jax, jax.numpy as jnp
from jax import lax
import numpy as np

D_MODEL = 1024
BATCH = 8
SEQ = 4096
DEPTH = 4

N_A_LAYERS = DEPTH // 2
N_B_LAYERS = DEPTH - N_A_LAYERS
MAIN_W = 3 * D_MODEL // 4
MEM_W = D_MODEL // 4
MIX_W = MAIN_W + MEM_W
GLA_HEADS = 4
GLA_DK = MAIN_W // 2
GLA_DV = MAIN_W
GLA_DK_HEAD = GLA_DK // GLA_HEADS
GLA_DV_HEAD = GLA_DV // GLA_HEADS
GLA_GATE_RANK = 16
GLA_GATE_TEMP = 16.0
GLA_CHUNK = 64
FOX_HEADS = 6
FOX_HEAD_DIM = MAIN_W // FOX_HEADS
FOX_BLOCK_Q = 128
FOX_FGATE_BIAS_INIT = 3.0
MEM_HEADS = 4
MEM_HEAD_DIM = MEM_W // MEM_HEADS
MEM_LEN = 256
D_FF = 256 * ((8 * D_MODEL // 3 + 255) // 256)
EPS = 1e-6
A_IN_W = 2 * GLA_DK + 2 * GLA_DV + GLA_GATE_RANK + MEM_W
B_IN_W = MAIN_W + MEM_W

kernel_name = "yoco_gla_fox_macaron_memory"


def rmsnorm(x, g):
    xf = x.astype(jnp.float32)
    y = xf * lax.rsqrt(jnp.mean(xf * xf, axis=-1, keepdims=True) + EPS)
    return (y * g.astype(jnp.float32)).astype(x.dtype)


def split_heads(t, n):
    b, s, w = t.shape
    return t.reshape(b, s, n, w // n).transpose(0, 2, 1, 3)


def merge_heads(t):
    b, n, s, d = t.shape
    return t.transpose(0, 2, 1, 3).reshape(b, s, n * d)


def swiglu_half_step(h, g, w_in, w_out):
    u = rmsnorm(h, g) @ w_in
    a, c = jnp.split(u, 2, axis=-1)
    return h + 0.5 * ((jax.nn.silu(a) * c) @ w_out)


def memory_attention(q_mem, mem_n, w_mem_kv):
    k, v = jnp.split(mem_n @ w_mem_kv, 2, axis=-1)
    q = split_heads(q_mem, MEM_HEADS)
    k = split_heads(k, MEM_HEADS)
    v = split_heads(v, MEM_HEADS)
    logits = jnp.einsum('bhqd,bhkd->bhqk', q, k).astype(jnp.float32) * (MEM_HEAD_DIM ** -0.5)
    p = jax.nn.softmax(logits, axis=-1).astype(v.dtype)
    return merge_heads(jnp.einsum('bhqk,bhkd->bhqd', p, v))


def gla_chunked(q, k, v, log_a):
    b, nh, s, dk = q.shape
    dv = v.shape[-1]
    nc = s // GLA_CHUNK

    def chunks(t):
        return t.astype(jnp.float32).reshape(b, nh, nc, GLA_CHUNK, t.shape[-1]).transpose(2, 0, 1, 3, 4)

    causal = jnp.tril(jnp.ones((GLA_CHUNK, GLA_CHUNK), dtype=bool))[:, :, None]

    def step(state, inp):
        qc, kc, vc, gc = inp
        cum = jnp.cumsum(gc, axis=2)
        o_inter = jnp.einsum('bhid,bhde->bhie', qc * jnp.exp(cum), state)
        diff = cum[:, :, :, None, :] - cum[:, :, None, :, :]
        decay = jnp.exp(jnp.where(causal, diff, -jnp.inf))
        scores = jnp.einsum('bhid,bhjd,bhijd->bhij', qc, kc, decay)
        o_intra = jnp.einsum('bhij,bhje->bhie', scores, vc)
        last = cum[:, :, -1:, :]
        k_dec = kc * jnp.exp(last - cum)
        state = jnp.exp(last[:, :, 0, :])[..., None] * state + jnp.einsum('bhjd,bhje->bhde', k_dec, vc)
        return state, o_inter + o_intra

    state0 = jnp.zeros((b, nh, dk, dv), jnp.float32)
    _, out = lax.scan(step, state0, (chunks(q), chunks(k), chunks(v), chunks(log_a)))
    return out.transpose(1, 2, 0, 3, 4).reshape(b, nh, s, dv)


def fox_attention(q, k, v, dcum):
    b, nh, s, dh = q.shape
    nb = s // FOX_BLOCK_Q
    qb = q.reshape(b, nh, nb, FOX_BLOCK_Q, dh).transpose(2, 0, 1, 3, 4)
    db = dcum.reshape(b, nh, nb, FOX_BLOCK_Q).transpose(2, 0, 1, 3)
    kpos = jnp.arange(s)
    scale = dh ** -0.5

    def block(args):
        i, qi, di = args
        logits = jnp.einsum('bhqd,bhkd->bhqk', qi, k).astype(jnp.float32) * scale
        logits = logits + di[..., :, None] - dcum[:, :, None, :]
        qpos = i * FOX_BLOCK_Q + jnp.arange(FOX_BLOCK_Q)
        logits = jnp.where(kpos[None, :] <= qpos[:, None], logits, -jnp.inf)
        p = jax.nn.softmax(logits, axis=-1).astype(v.dtype)
        return jnp.einsum('bhqk,bhkd->bhqd', p, v)

    out = lax.map(block, (jnp.arange(nb), qb, db))
    return out.transpose(1, 2, 0, 3, 4).reshape(b, nh, s, dh)


def gla_mixer(xn, mem_n, w_in, w_gate_up, b_gate, g_head, w_mem_kv, w_out):
    proj = xn @ w_in
    o1 = GLA_DK
    o2 = o1 + GLA_DK
    o3 = o2 + GLA_DV
    o4 = o3 + GLA_DV
    o5 = o4 + GLA_GATE_RANK
    q, k, v, r, g_low, q_mem = (proj[..., :o1], proj[..., o1:o2], proj[..., o2:o3],
                                proj[..., o3:o4], proj[..., o4:o5], proj[..., o5:])
    log_a = jax.nn.log_sigmoid((g_low @ w_gate_up + b_gate).astype(jnp.float32)) / GLA_GATE_TEMP
    o = gla_chunked(split_heads(q * (GLA_DK_HEAD ** -0.5), GLA_HEADS), split_heads(k, GLA_HEADS),
                    split_heads(v, GLA_HEADS), split_heads(log_a, GLA_HEADS))
    o = rmsnorm(o, g_head).astype(xn.dtype)
    o_main = merge_heads(o) * jax.nn.silu(r)
    o_mem = memory_attention(q_mem, mem_n, w_mem_kv)
    return jnp.concatenate([o_main, o_mem], axis=-1) @ w_out


def fox_mixer(xn, mem_n, w_in, k_sh, v_sh, dcum_sh, w_mem_kv, w_out):
    proj = xn @ w_in
    q, q_mem = proj[..., :MAIN_W], proj[..., MAIN_W:]
    o_main = merge_heads(fox_attention(split_heads(q, FOX_HEADS), k_sh, v_sh, dcum_sh))
    o_mem = memory_attention(q_mem, mem_n, w_mem_kv)
    return jnp.concatenate([o_main, o_mem], axis=-1) @ w_out


def setup_inputs(seed: int = 0) -> dict:
    key = jax.random.key(seed)
    ks = jax.random.split(key, 20)

    def dense(k, shape, fan_in, scale=1.0):
        return jax.random.normal(k, shape, jnp.float32) * (scale * fan_in ** -0.5)

    def gain(k, shape):
        return 1.0 + 0.02 * jax.random.normal(k, shape, jnp.float32)

    return {
        "x": jax.random.normal(ks[0], (BATCH, SEQ, D_MODEL), jnp.float32),
        "mem": jax.random.normal(ks[1], (BATCH, MEM_LEN, D_MODEL), jnp.float32),
        "norm_ffn": gain(ks[2], (DEPTH, 2, D_MODEL)),
        "w_ffn_in": dense(ks[3], (DEPTH, 2, D_MODEL, 2 * D_FF), D_MODEL),
        "w_ffn_out": dense(ks[4], (DEPTH, 2, D_FF, D_MODEL), D_FF, 0.5),
        "norm_mix": gain(ks[5], (DEPTH, D_MODEL)),
        "norm_mem": gain(ks[6], (DEPTH, D_MODEL)),
        "w_mem_kv": dense(ks[7], (DEPTH, D_MODEL, 2 * MEM_W), D_MODEL),
        "w_out": dense(ks[8], (DEPTH, MIX_W, D_MODEL), MIX_W, 0.5),
        "w_in_a": dense(ks[9], (N_A_LAYERS, D_MODEL, A_IN_W), D_MODEL),
        "w_gate_up": dense(ks[10], (N_A_LAYERS, GLA_GATE_RANK, GLA_DK), GLA_GATE_RANK),
        "b_gate": 0.1 * jax.random.normal(ks[11], (N_A_LAYERS, GLA_DK), jnp.float32),
        "norm_gla_head": gain(ks[12], (N_A_LAYERS, GLA_DV_HEAD)),
        "w_in_b": dense(ks[13], (N_B_LAYERS, D_MODEL, B_IN_W), D_MODEL),
        "norm_shared": gain(ks[14], (D_MODEL,)),
        "w_kv_shared": dense(ks[15], (D_MODEL, 2 * MAIN_W), D_MODEL),
        "w_fgate": dense(ks[16], (D_MODEL, FOX_HEADS), D_MODEL),
        "b_fgate": FOX_FGATE_BIAS_INIT + 0.1 * jax.random.normal(ks[17], (FOX_HEADS,), jnp.float32),
        "norm_final": gain(ks[18], (D_MODEL,)),
    }


def reference(x, mem, norm_ffn, w_ffn_in, w_ffn_out, norm_mix, norm_mem, w_mem_kv, w_out,
              w_in_a, w_gate_up, b_gate, norm_gla_head, w_in_b, norm_shared, w_kv_shared,
              w_fgate, b_fgate, norm_final):
    h = x
    k_sh = v_sh = dcum_sh = None
    for l in range(DEPTH):
        if l == N_A_LAYERS:
            hs = rmsnorm(h, norm_shared)
            k_all, v_all = jnp.split(hs @ w_kv_shared, 2, axis=-1)
            k_sh = split_heads(k_all, FOX_HEADS)
            v_sh = split_heads(v_all, FOX_HEADS)
            log_f = jax.nn.log_sigmoid((hs @ w_fgate + b_fgate).astype(jnp.float32))
            dcum_sh = jnp.cumsum(log_f, axis=1).transpose(0, 2, 1)
        h = swiglu_half_step(h, norm_ffn[l, 0], w_ffn_in[l, 0], w_ffn_out[l, 0])
        xn = rmsnorm(h, norm_mix[l])
        mem_n = rmsnorm(mem, norm_mem[l])
        if l < N_A_LAYERS:
            mixed = gla_mixer(xn, mem_n, w_in_a[l], w_gate_up[l], b_gate[l], norm_gla_head[l],
                              w_mem_kv[l], w_out[l])
        else:
            j = l - N_A_LAYERS
            mixed = fox_mixer(xn, mem_n, w_in_b[j], k_sh, v_sh, dcum_sh, w_mem_kv[l], w_out[l])
        h = h + mixed
        h = swiglu_half_step(h, norm_ffn[l, 1], w_ffn_in[l, 1], w_ffn_out[l, 1])
    return rmsnorm(h, norm_final)
```

```cpp
#include <hip/hip_runtime.h>
#include <cstdio>
#include <cstdint>
#include <cmath>
namespace pg8 {
#define PG8_LAS __attribute__((address_space(3)))
typedef unsigned short bf16_t;
typedef short bf16x8 __attribute__((ext_vector_type(8)));
typedef float f32x4 __attribute__((ext_vector_type(4)));
typedef unsigned u32x4 __attribute__((ext_vector_type(4)));
constexpr int BM = 256, BK = 64, HALF = 128, HTB = HALF * BK * 2  , STAGE_BYTES = 8 * HTB, NXCD = 8, WGM = 8;

__host__ __device__ __forceinline__ int lds_byte(int r, int c) { const int st = (r >> 4) * 2 + (c >> 5), rr = r & 15, cc = c & 31, ob = rr * 64 + cc * 2; return st * 1024 + (ob ^ (((ob >> 9) & 1) << 5)); }
__host__ __device__ __forceinline__ void stage_rc(int b, int& R, int& C) { const int st = b / 1024, sb = b % 1024, swz = sb ^ (((sb >> 9) & 1) << 5); R = (st >> 1) * 16 + swz / 64; C = (st & 1) * 32 + (swz % 64) / 2; }
__host__ __device__ __forceinline__ int perm32(int rho) { const int n = rho >> 4, i = rho & 15; return 8 * (i >> 2) + 4 * n + (i & 3); }

struct Unit { int pm, pn; };
struct Gemm { const bf16_t* A; const bf16_t* Bt; int M, N, K; };

struct StaticOrder {
    int nM, nN, nwg, G, c;
    __host__ __device__ void init(int M, int N, int G_, int c_) { nM = M / BM; nN = N / BM; nwg = nM * nN; G = G_; c = c_; }
    __host__ __device__ bool next(int i, Unit& u) const {
        const long L = (long)i * G + c; if (L >= nwg) return false;
        int wgid = (int)L; { const int q = nwg / NXCD, r = nwg % NXCD, xcd = wgid % NXCD, off = wgid / NXCD; wgid = (xcd < r ? xcd * (q + 1) : r * (q + 1) + (xcd - r) * q) + off; }
        const int nig = WGM * nN, gid = wgid / nig, fm = gid * WGM, gsz = (nM - fm) < WGM ? (nM - fm) : WGM;
        u.pm = fm + ((wgid % nig) % gsz); u.pn = (wgid % nig) / gsz; return true;
    }
    __device__ __forceinline__ void a_ready(const Unit&) const {}
    __device__ __forceinline__ void done(const Unit&) const {}
};

__device__ __forceinline__ unsigned cvt_pk_bf16(float lo, float hi) { unsigned r; asm volatile("v_cvt_pk_bf16_f32 %0, %1, %2" : "=v"(r) : "v"(lo), "v"(hi)); return r; }
typedef float f32x2 __attribute__((ext_vector_type(2)));
__device__ __forceinline__ float silu_f(float a) { return a * __builtin_amdgcn_rcpf(1.0f + __builtin_amdgcn_exp2f(-1.4426950408889634f * a)); }
struct EpiBf16 {
    static constexpr bool PERM = true, AFTER_DRAIN = false;
    bf16_t* O; int ldc;
    __device__ __forceinline__ void operator()(const f32x4 (&acc)[2][2][4][2], const Unit& u, int wr, int wc, int fr, int fq) const {
        const int row0 = u.pm * BM + wr * 64 + fr, col0 = u.pn * BM + wc * 32 + 8 * fq;
#pragma unroll
        for (int ai = 0; ai < 2; ++ai)
#pragma unroll
            for (int m = 0; m < 4; ++m) { bf16_t* rowp = O + (size_t)(row0 + ai * HALF + m * 16) * ldc + col0;
#pragma unroll
                for (int bj = 0; bj < 2; ++bj) { const f32x4 v0 = acc[ai][bj][m][0], v1 = acc[ai][bj][m][1];
                    u32x4 w; w.x = cvt_pk_bf16(v0[0], v0[1]); w.y = cvt_pk_bf16(v0[2], v0[3]); w.z = cvt_pk_bf16(v1[0], v1[1]); w.w = cvt_pk_bf16(v1[2], v1[3]);
                    *(u32x4*)(rowp + bj * HALF) = w; } }
    }
};
struct EpiSwiGLU {
    static constexpr bool PERM = true, AFTER_DRAIN = false;
    bf16_t* O; int ldc;
    __device__ __forceinline__ void operator()(const f32x4 (&acc)[2][2][4][2], const Unit& u, int wr, int wc, int fr, int fq) const {
        const int row0 = u.pm * BM + wr * 64 + fr, col0 = u.pn * HALF + wc * 32 + 8 * fq;
#pragma unroll
        for (int ai = 0; ai < 2; ++ai)
#pragma unroll
            for (int m = 0; m < 4; ++m) { bf16_t* rowp = O + (size_t)(row0 + ai * HALF + m * 16) * ldc + col0;
                const f32x4 a0 = acc[ai][0][m][0], a1 = acc[ai][0][m][1], c0 = acc[ai][1][m][0], c1 = acc[ai][1][m][1];
                u32x4 w; w.x = cvt_pk_bf16(silu_f(a0[0]) * c0[0], silu_f(a0[1]) * c0[1]); w.y = cvt_pk_bf16(silu_f(a0[2]) * c0[2], silu_f(a0[3]) * c0[3]);
                w.z = cvt_pk_bf16(silu_f(a1[0]) * c1[0], silu_f(a1[1]) * c1[1]); w.w = cvt_pk_bf16(silu_f(a1[2]) * c1[2], silu_f(a1[3]) * c1[3]);
                *(u32x4*)rowp = w; }
    }
};
struct EpiResid {
    static constexpr bool PERM = false, AFTER_DRAIN = false;
    float* H; int ldc; float scale;
    __device__ __forceinline__ void operator()(const f32x4 (&acc)[2][2][4][2], const Unit& u, int wr, int wc, int fr, int fq) const {
        const int row0 = u.pm * BM + wr * 64 + fr, col0 = u.pn * BM + wc * 32 + 4 * fq;
#pragma unroll
        for (int ai = 0; ai < 2; ++ai)
#pragma unroll
            for (int m = 0; m < 4; ++m) { float* rowp = H + (size_t)(row0 + ai * HALF + m * 16) * ldc + col0;
#pragma unroll
                for (int bj = 0; bj < 2; ++bj)
#pragma unroll
                    for (int n = 0; n < 2; ++n) { f32x4* p = (f32x4*)(rowp + bj * HALF + n * 16); const f32x4 b = *p; *p = b + acc[ai][bj][m][n] * scale; }
                if (m & 1) asm volatile("" ::: "memory"); }
    }
};
template <class Epi, class Sched, bool ALIGN_EPI = false, bool SP2 = false>
__device__ __forceinline__ void gemm_phase(PG8_LAS unsigned char* lds, const Gemm g, const Sched& S, const Epi& E) {
    int tid_o = threadIdx.x; asm volatile("" : "+v"(tid_o));
    const int tid = tid_o, wid = __builtin_amdgcn_readfirstlane(tid >> 6), lane = tid & 63, wr = wid >> 2, wc = wid & 3, fr = lane & 15, fq = lane >> 4;
    const int K = g.K, nt = K / BK;
    unsigned voffA[2], voffB[2];
#pragma unroll
    for (int i = 0; i < 2; ++i) { int R, C; stage_rc(tid * 16 + i * 8192, R, C); const int Rb = Epi::PERM ? ((R & ~31) + perm32(R & 31)) : R;
        voffA[i] = (unsigned)(R * K + C) * 2u; voffB[i] = (unsigned)(Rb * K + C) * 2u; }
    const size_t kstep = (size_t)(BK * 2);
    const size_t hstep = (size_t)HALF * K * 2;
    const size_t tstep = 2 * hstep;
    const unsigned ldsw = (unsigned)wid * 1024u;
    const int aoff = lds_byte(wr * 64 + fr, fq * 8), boff = lds_byte(wc * 32 + fr, fq * 8);
#define PG8_SA(b, h) (((b) * 2 + (h)) * HTB)
#define PG8_SB(b, h) ((4 + (b) * 2 + (h)) * HTB)
#define PG8_STAGE(bufoff, gbase, voff) do { _Pragma("unroll") for (int _i = 0; _i < 2; ++_i) \
        __builtin_amdgcn_global_load_lds((const unsigned*)((const char*)(gbase) + (voff)[_i]), (PG8_LAS unsigned*)(lds + (bufoff) + ldsw + _i * 8192), 16, 0, 0); } while (0)
#define PG8_LDA(dst, b, h) do { _Pragma("unroll") for (int m = 0; m < 4; ++m) _Pragma("unroll") for (int k = 0; k < 2; ++k) dst[m][k] = *(const PG8_LAS bf16x8*)(lds + PG8_SA(b, h) + aoff + m * 2048 + k * 1024); } while (0)
#define PG8_LDB(dst, b, h) do { _Pragma("unroll") for (int n = 0; n < 2; ++n) _Pragma("unroll") for (int k = 0; k < 2; ++k) dst[n][k] = *(const PG8_LAS bf16x8*)(lds + PG8_SB(b, h) + boff + n * 2048 + k * 1024); } while (0)
#define PG8_MMA(ai, bj, At, Bt) do { __builtin_amdgcn_s_setprio(1); _Pragma("unroll") for (int m = 0; m < 4; ++m) _Pragma("unroll") for (int n = 0; n < 2; ++n) _Pragma("unroll") for (int k = 0; k < 2; ++k) \
        acc[ai][bj][m][n] = __builtin_amdgcn_mfma_f32_16x16x32_bf16(Bt[n][k], At[m][k], acc[ai][bj][m][n], 0, 0, 0); __builtin_amdgcn_s_setprio(0); } while (0)
#define PG8_WAIT_V(n) asm volatile("s_waitcnt vmcnt(" #n ")" ::: "memory")
#define PG8_WAIT_L(n) asm volatile("s_waitcnt lgkmcnt(" #n ")" ::: "memory")
#define PG8_BAR __builtin_amdgcn_s_barrier()
#define PG8_SCHED __builtin_amdgcn_sched_barrier(0)
    Unit cur, nxt; int ui = 0;
    if (!S.next(0, cur)) return;
    f32x4 acc[2][2][4][2];
#pragma unroll
    for (int a = 0; a < 2; ++a)
#pragma unroll
        for (int b = 0; b < 2; ++b)
#pragma unroll
            for (int m = 0; m < 4; ++m)
#pragma unroll
                for (int n = 0; n < 2; ++n) acc[a][b][m][n] = (f32x4){0.f, 0.f, 0.f, 0.f};
    bf16x8 At[4][2], B0[2][2], B1[2][2];
    const char* cA = (const char*)g.A + (size_t)cur.pm * tstep; const char* cB = (const char*)g.Bt + (size_t)cur.pn * tstep;
    S.a_ready(cur);
    if constexpr (SP2) {
        PG8_STAGE(PG8_SB(0, 0), cB, voffB); PG8_STAGE(PG8_SB(0, 1), cB + hstep, voffB); PG8_STAGE(PG8_SA(0, 0), cA, voffA); PG8_STAGE(PG8_SA(0, 1), cA + hstep, voffA);
        if (wr == 1) PG8_BAR;
        PG8_WAIT_V(2); PG8_BAR;
        PG8_STAGE(PG8_SB(1, 0), cB + kstep, voffB); PG8_STAGE(PG8_SA(1, 0), cA + kstep, voffA); PG8_STAGE(PG8_SB(1, 1), cB + hstep + kstep, voffB);
        PG8_WAIT_V(6); PG8_BAR;
    } else {
        PG8_STAGE(PG8_SB(0, 0), cB, voffB); PG8_STAGE(PG8_SA(0, 0), cA, voffA); PG8_STAGE(PG8_SB(0, 1), cB + hstep, voffB); PG8_STAGE(PG8_SA(0, 1), cA + hstep, voffA);
        if (wr == 1) PG8_BAR;
        PG8_WAIT_V(4); PG8_BAR;
        PG8_STAGE(PG8_SB(1, 0), cB + kstep, voffB); PG8_STAGE(PG8_SA(1, 0), cA + kstep, voffA); PG8_STAGE(PG8_SB(1, 1), cB + hstep + kstep, voffB);
        PG8_WAIT_V(6); PG8_BAR;
    }
    for (;;) {
        const bool has_next = S.next(ui + 1, nxt);
        const char* nA = has_next ? (const char*)g.A + (size_t)nxt.pm * tstep : cA; const char* nB = has_next ? (const char*)g.Bt + (size_t)nxt.pn * tstep : cB;
        for (int t = 0; t < nt; t += 2) {
            const bool last = (t == nt - 2);
            const char* a1 = cA + (size_t)(t + 1) * kstep;
            const char* a2 = last ? nA : cA + (size_t)(t + 2) * kstep; const char* b2 = last ? nB : cB + (size_t)(t + 2) * kstep;
            const char* a3 = a2 + kstep; const char* b3 = b2 + kstep;
            if (last && has_next) S.a_ready(nxt);
            if constexpr (SP2) {
            PG8_LDB(B0, 0, 0); PG8_LDB(B1, 0, 1); PG8_SCHED; PG8_LDA(At, 0, 0); PG8_STAGE(PG8_SA(1, 1), a1 + hstep, voffA);
            PG8_WAIT_V(8); PG8_WAIT_L(0); PG8_BAR; PG8_MMA(0, 0, At, B0); PG8_MMA(0, 1, At, B1); PG8_BAR; PG8_SCHED;
            PG8_LDA(At, 0, 1); PG8_STAGE(PG8_SB(0, 0), b2, voffB); PG8_STAGE(PG8_SB(0, 1), b2 + hstep, voffB); PG8_STAGE(PG8_SA(0, 0), a2, voffA);
            PG8_WAIT_V(8); PG8_WAIT_L(0); PG8_BAR; PG8_MMA(1, 0, At, B0); PG8_MMA(1, 1, At, B1); PG8_BAR; PG8_SCHED;
            PG8_LDB(B0, 1, 0); PG8_LDB(B1, 1, 1); PG8_SCHED; PG8_LDA(At, 1, 0); PG8_STAGE(PG8_SA(0, 1), a2 + hstep, voffA);
            PG8_WAIT_V(8); PG8_WAIT_L(0); PG8_BAR; PG8_MMA(0, 0, At, B0); PG8_MMA(0, 1, At, B1); PG8_BAR; PG8_SCHED;
            PG8_LDA(At, 1, 1); PG8_STAGE(PG8_SB(1, 0), b3, voffB); PG8_STAGE(PG8_SB(1, 1), b3 + hstep, voffB); PG8_STAGE(PG8_SA(1, 0), a3, voffA);
            PG8_WAIT_V(8); PG8_WAIT_L(0); PG8_BAR; PG8_MMA(1, 0, At, B0); PG8_MMA(1, 1, At, B1); PG8_BAR; PG8_SCHED;
            } else {
            PG8_LDB(B0, 0, 0); PG8_SCHED; PG8_LDA(At, 0, 0); PG8_STAGE(PG8_SA(1, 1), a1 + hstep, voffA);
            PG8_WAIT_L(8); PG8_BAR; PG8_WAIT_L(0); PG8_MMA(0, 0, At, B0); PG8_BAR; PG8_SCHED;
            PG8_LDB(B1, 0, 1); PG8_STAGE(PG8_SB(0, 0), b2, voffB);
            PG8_BAR; PG8_WAIT_L(0); PG8_MMA(0, 1, At, B1); PG8_BAR;
            PG8_LDA(At, 0, 1); PG8_STAGE(PG8_SA(0, 0), a2, voffA);
            PG8_BAR; PG8_WAIT_L(0); PG8_MMA(1, 0, At, B0); PG8_BAR; PG8_SCHED;
            PG8_STAGE(PG8_SB(0, 1), b2 + hstep, voffB);
            PG8_WAIT_V(6); PG8_BAR; PG8_MMA(1, 1, At, B1); PG8_BAR;
            PG8_LDB(B0, 1, 0); PG8_SCHED; PG8_LDA(At, 1, 0); PG8_STAGE(PG8_SA(0, 1), a2 + hstep, voffA);
            PG8_WAIT_L(8); PG8_BAR; PG8_WAIT_L(0); PG8_MMA(0, 0, At, B0); PG8_BAR; PG8_SCHED;
            PG8_LDB(B1, 1, 1); PG8_STAGE(PG8_SB(1, 0), b3, voffB);
            PG8_BAR; PG8_WAIT_L(0); PG8_MMA(0, 1, At, B1); PG8_BAR;
            PG8_LDA(At, 1, 1); PG8_STAGE(PG8_SA(1, 0), a3, voffA);
            PG8_BAR; PG8_WAIT_L(0); PG8_MMA(1, 0, At, B0); PG8_BAR; PG8_SCHED;
            PG8_STAGE(PG8_SB(1, 1), b3 + hstep, voffB);
            PG8_WAIT_V(6); PG8_BAR; PG8_MMA(1, 1, At, B1); PG8_BAR;
            }
        }
        if constexpr (ALIGN_EPI) { if (wr == 0) PG8_BAR; }
        if constexpr (!Epi::AFTER_DRAIN) { E(acc, cur, wr, wc, fr, fq); S.done(cur); }
        if (!has_next) break;
#pragma unroll
        for (int a = 0; a < 2; ++a)
#pragma unroll
            for (int b = 0; b < 2; ++b)
#pragma unroll
                for (int m = 0; m < 4; ++m)
#pragma unroll
                    for (int n = 0; n < 2; ++n) acc[a][b][m][n] = (f32x4){0.f, 0.f, 0.f, 0.f};
        cur = nxt; cA = nA; cB = nB; ++ui;
        if constexpr (ALIGN_EPI) { if (wr == 1) PG8_BAR; }
    }
    PG8_WAIT_V(0);
    if constexpr (!ALIGN_EPI) { if (wr == 0) PG8_BAR; }
    PG8_BAR;
    if constexpr (Epi::AFTER_DRAIN) { E.fused(acc, cur, wr, wc, fr, fq, lds, wid, lane); S.done(cur); }
#undef PG8_SA
#undef PG8_SB
#undef PG8_STAGE
#undef PG8_LDA
#undef PG8_LDB
#undef PG8_MMA
#undef PG8_WAIT_V
#undef PG8_WAIT_L
#undef PG8_BAR
#undef PG8_SCHED
}
}
constexpr int NWAVES = 8, NTHR = 512;
constexpr int BATCH = 8, SEQ = 4096, DM = 1024, DEPTH = 4, M = BATCH * SEQ;
constexpr int DFF = 2816, NFF1 = 2 * DFF;
constexpr int GLA_H = 4, GLA_DK = 384, GLA_DV = 768, GLA_DKH = 96, GLA_DVH = 192, GLA_R = 16;
constexpr int FOX_H = 6, FOX_DH = 128, MAIN_W = 768, MEM_W = 256, MEM_H = 4, MEM_DH = 64, MEM_LEN = 256;
constexpr int A_IN_W = 2576, NA = 2816  , NB = 1024, NKV = 1536;
constexpr int PA_Q = 0, PA_K = 384, PA_V = 768, PA_R = 1536, PA_QM = 2304, PA_GL = 2560;
constexpr float EPS = 1e-6f;
constexpr int MEMROWS = BATCH * MEM_LEN;
constexpr int NMEMKV = DEPTH * 2 * MEM_W;

constexpr size_t MiB = 1u << 20;
constexpr size_t WS_CTL = 0, CTL_ZERO_BYTES = 1 * MiB;
constexpr size_t WS_W1 = 1 * MiB;
constexpr size_t WS_W2 = WS_W1 + 88 * MiB;
constexpr size_t WS_WA = WS_W2 + 44 * MiB;
constexpr size_t WS_WB = WS_WA + 11 * MiB;
constexpr size_t WS_WO = WS_WB + 4 * MiB;
constexpr size_t WS_WKV = WS_WO + 8 * MiB;
constexpr size_t WS_WM = WS_WKV + 3 * MiB;
constexpr size_t WS_XN = WS_WM + 4 * MiB;
constexpr size_t WS_KV = WS_XN + 64 * MiB;
constexpr size_t WS_MEMN = WS_KV + 96 * MiB;
constexpr size_t WS_MEMKV = WS_MEMN + 4 * MiB;
constexpr size_t WS_SMALL = WS_MEMKV + 8 * MiB;
constexpr size_t WS_R1 = WS_SMALL + 2 * MiB;
constexpr size_t WS_R2 = WS_R1 + 176 * MiB;
constexpr size_t WS_END = WS_R2 + 176 * MiB;
static_assert(WS_END == 689 * MiB, "ws map");
constexpr int CW_BAR = 4096;

constexpr int RING_OFF = 0, RING_BYTES = 131072;
constexpr int LDSCTL_OFF = RING_BYTES, MISC_OFF = LDSCTL_OFF + 320;
constexpr int LDS_BYTES = 147456;
#define GAS __attribute__((address_space(1)))
#define LAS __attribute__((address_space(3)))
typedef unsigned short bf16;
typedef unsigned v4u __attribute__((ext_vector_type(4)));
typedef float f32x4 __attribute__((ext_vector_type(4)));
typedef short bf16x8 __attribute__((ext_vector_type(8)));
typedef GAS unsigned gu32;
typedef GAS unsigned long long gu64;
#define RLX_AGENT __ATOMIC_RELAXED, __HIP_MEMORY_SCOPE_AGENT
#define LDS_WAIT() asm volatile("s_waitcnt lgkmcnt(0)" ::: "memory")
#define VM_WAIT() asm volatile("s_waitcnt vmcnt(0)" ::: "memory")
__device__ __forceinline__ unsigned long long rt() { return __builtin_amdgcn_s_memrealtime(); }
__device__ __forceinline__ unsigned f2bf(float f) { unsigned u = __builtin_bit_cast(unsigned, f); return (u + 0x7fffu + ((u >> 16) & 1u)) >> 16; }
__device__ __forceinline__ unsigned pk2(float lo, float hi) { return f2bf(lo) | (f2bf(hi) << 16); }

#define XB_TMO      128
#define XB_XCNT(j)  (256  + 64 * (j))
#define XB_XSUB(j)  (1280 + 64 * (j))
#define XB_XGEN(j)  (2304 + 64 * (j))
#define XB_TOP      3328
#define XB_TOPGEN   3392
#define XCD_BAR_WORDS 3456
#define XB_SPIN_CAP (1u << 18)

__device__ __forceinline__ unsigned xb_ld(unsigned* p)              { return __hip_atomic_load(p, __ATOMIC_RELAXED, __HIP_MEMORY_SCOPE_AGENT); }
__device__ __forceinline__ unsigned xb_add(unsigned* p, unsigned v) { return __hip_atomic_fetch_add(p, v, __ATOMIC_RELAXED, __HIP_MEMORY_SCOPE_AGENT); }
__device__ __forceinline__ unsigned xb_xcc_id() { return (unsigned)__builtin_amdgcn_s_getreg((3 << 11) | 20) & 0xFu; }
#define XB_SPIN(cond, bar) do { unsigned _sp = 0; while (cond) { __builtin_amdgcn_s_sleep(1); \
    if ((++_sp & 255u) == 0u) { if (xb_ld(&(bar)[XB_TMO])) break; if (_sp > XB_SPIN_CAP) { atomicAdd(&(bar)[XB_TMO], 1u); break; } } } } while (0)

struct XcdBarrier {
    unsigned* bar; unsigned x;
    volatile LAS unsigned* st;
};

__device__ __forceinline__ XcdBarrier xcd_barrier_post(unsigned* bar, volatile LAS unsigned* st) {
    XcdBarrier b; b.bar = bar; b.x = xb_xcc_id(); b.st = st;
    if (threadIdx.x == 0) (void)xb_add(&bar[XB_XCNT(b.x)], 1u);
    return b;
}
__device__ __forceinline__ void xcd_barrier_complete(unsigned* bar, unsigned x, unsigned& nloc, unsigned& nx) {
    const unsigned G = gridDim.x * gridDim.y * gridDim.z;
    unsigned sum, cnt, mine, sp = 0u;
    for (;;) {
        sum = 0u; cnt = 0u; mine = 0u;
#pragma unroll
        for (unsigned j = 0; j < 16; ++j) { const unsigned c = xb_ld(&bar[XB_XCNT(j)]); sum += c; cnt += (c > 0u) ? 1u : 0u; mine = (j == x) ? c : mine; }
        if (sum == G) break;
        __builtin_amdgcn_s_sleep(1);
        if ((++sp & 255u) == 0u) { if (xb_ld(&bar[XB_TMO])) break; if (sp > XB_SPIN_CAP) { atomicAdd(&bar[XB_TMO], 1u); break; } }
    }
    nloc = mine > 0u ? mine : 1u; nx = cnt > 0u ? cnt : 1u;
}

__device__ __forceinline__ void xcd_barrier(const XcdBarrier& b) {
    asm volatile("s_waitcnt vmcnt(0)" ::: "memory");
    __syncthreads();
    if (threadIdx.x == 0) {
        unsigned* bar = b.bar;
        __builtin_amdgcn_s_waitcnt(0);
        unsigned nloc = b.st[0], nx = b.st[1];
        if (nloc == 0u) { xcd_barrier_complete(bar, b.x, nloc, nx); b.st[0] = nloc; b.st[1] = nx; }
        const unsigned old = xb_add(&bar[XB_XSUB(b.x)], 1u);
        const unsigned gen = old / nloc;
        if (old + 1u == (gen + 1u) * nloc) {
            __builtin_amdgcn_fence(__ATOMIC_RELEASE, "agent");
            asm volatile("s_waitcnt vmcnt(0)" ::: "memory");
            const unsigned og = xb_add(&bar[XB_TOP], 1u);
            const unsigned tg = og / nx;
            if (og + 1u == (tg + 1u) * nx) xb_add(&bar[XB_TOPGEN], 1u);
            else XB_SPIN(xb_ld(&bar[XB_TOPGEN]) == tg, bar);
            __builtin_amdgcn_fence(__ATOMIC_ACQUIRE, "agent");
            xb_add(&bar[XB_XGEN(b.x)], 1u);
            asm volatile("s_waitcnt vmcnt(0)" ::: "memory");
        } else {
            XB_SPIN(xb_ld(&bar[XB_XGEN(b.x)]) == gen, bar);
            __builtin_amdgcn_fence(__ATOMIC_ACQUIRE, "agent");
            asm volatile("s_waitcnt vmcnt(0)" ::: "memory");
        }
    }
    __syncthreads();
}
__device__ __forceinline__ float wave_sum(float v) {
#pragma unroll
    for (int o = 1; o < 64; o <<= 1) v += __shfl_xor(v, o);
    return v;
}
__device__ __forceinline__ float bf2f(bf16 b) { return __builtin_bit_cast(float, (unsigned)b << 16); }
__device__ __forceinline__ float log_sigmoid_f(float z) { return fminf(z, 0.f) - log1pf(expf(-fabsf(z))); }

struct MapPlain { __device__ __forceinline__ void operator()(int r, int& sc, float& cs) const { sc = r; cs = 1.f; } };
struct MapSwi   { __device__ __forceinline__ void operator()(int r, int& sc, float& cs) const { const int pn = r >> 8, x = r & 255; sc = x < 128 ? 128 * pn + x : DFF + 128 * pn + (x - 128); cs = 1.f; } };
struct MapInA   { __device__ __forceinline__ void operator()(int r, int& sc, float& cs) const {
    if (r < PA_QM) { sc = r; cs = r < GLA_DK ? 0.10206207261596575f   : 1.f; }
    else if (r < PA_GL) { sc = r + GLA_R; cs = 0.125f; }
    else if (r < PA_GL + GLA_R) { sc = r - MEM_W; cs = 1.f; }
    else { sc = -1; cs = 0.f; } } };
struct MapInB   { __device__ __forceinline__ void operator()(int r, int& sc, float& cs) const { sc = r; cs = r < MAIN_W ? 1.f : 0.125f; } };
template <class Map>
__device__ __forceinline__ void transpose_item(const float* W, int K, int N, int NR, bf16* WT, LAS float* scr, int item, int lane, const float* kscale, Map map) {
    const int nblk = NR / 32, kb = item / nblk, nb = item % nblk, k0 = 64 * kb, n0 = 32 * nb;
    int sc; float cs; map(n0 + (lane & 31), sc, cs);
#pragma unroll 8
    for (int i = 0; i < 32; ++i) { const int kk = 2 * i + (lane >> 5); float v = 0.f;
        if (sc >= 0) v = W[(size_t)(k0 + kk) * N + sc] * cs;
        if (kscale) v *= kscale[k0 + kk];
        scr[kk * 33 + (lane & 31)] = v; }
    LDS_WAIT(); asm volatile("" ::: "memory");
    const int c = lane & 7;
#pragma unroll
    for (int j = 0; j < 4; ++j) { const int n = (lane >> 3) + 8 * j; const LAS float* s = scr + (8 * c) * 33 + n;
        v4u o; o.x = pk2(s[0 * 33], s[1 * 33]); o.y = pk2(s[2 * 33], s[3 * 33]); o.z = pk2(s[4 * 33], s[5 * 33]); o.w = pk2(s[6 * 33], s[7 * 33]);
        *(GAS v4u*)(WT + (size_t)(n0 + n) * K + k0 + 8 * c) = o; }
    LDS_WAIT(); asm volatile("" ::: "memory");
}

struct NormArgs { const float* src; const float* gain; bf16* xn; float* hcopy; float* outf; const float* wf; const float* bfg; float* logf; int rows; int mode; };
__device__ __forceinline__ void norm_phase(const NormArgs& a, int gw, int NGW, int lane) {
    for (int m = gw; m < a.rows; m += NGW) {
        const GAS f32x4* xr = (const GAS f32x4*)(a.src + (size_t)m * DM) + lane;
        f32x4 v[4]; float s = 0.f;
#pragma unroll
        for (int j = 0; j < 4; ++j) { v[j] = xr[64 * j]; s += (v[j].x * v[j].x + v[j].y * v[j].y) + (v[j].z * v[j].z + v[j].w * v[j].w); }
        if (a.mode & 1) { GAS f32x4* hr = (GAS f32x4*)(a.hcopy + (size_t)m * DM) + lane;
#pragma unroll
            for (int j = 0; j < 4; ++j) hr[64 * j] = v[j]; }
        const float rstd = 1.0f / sqrtf(wave_sum(s) * (1.f / DM) + EPS);
#pragma unroll
        for (int j = 0; j < 4; ++j) { f32x4 g = (f32x4){1.f, 1.f, 1.f, 1.f}; if (!(a.mode & 8)) g = ((const GAS f32x4*)a.gain)[lane + 64 * j]; v[j] = v[j] * rstd * g; }
        if (a.mode & 2) { GAS f32x4* o = (GAS f32x4*)(a.outf + (size_t)m * DM) + lane;
#pragma unroll
            for (int j = 0; j < 4; ++j) o[64 * j] = v[j]; }
        else { GAS unsigned long long* o8 = (GAS unsigned long long*)(a.xn + (size_t)m * DM) + lane;
#pragma unroll
            for (int j = 0; j < 4; ++j) o8[64 * j] = (unsigned long long)pk2(v[j].x, v[j].y) | ((unsigned long long)pk2(v[j].z, v[j].w) << 32); }
        if (a.mode & 4) {
            float z[FOX_H];
#pragma unroll
            for (int h = 0; h < FOX_H; ++h) z[h] = 0.f;
#pragma unroll
            for (int j = 0; j < 4; ++j) { const float* w = a.wf + (size_t)(4 * lane + 256 * j) * FOX_H;
#pragma unroll
                for (int e = 0; e < 4; ++e)
#pragma unroll
                    for (int h = 0; h < FOX_H; ++h) z[h] += v[j][e] * w[e * FOX_H + h]; }
#pragma unroll
            for (int h = 0; h < FOX_H; ++h) { const float t = wave_sum(z[h]) + a.bfg[h]; if (lane == 0) a.logf[(size_t)m * FOX_H + h] = log_sigmoid_f(t); }
        }
    }
}

__device__ __forceinline__ void dcum_phase(const float* logf, float* dcum, int gw, int NGW, int lane) {
    for (int q = gw; q < BATCH * FOX_H; q += NGW) {
        const int b = q / FOX_H, h = q % FOX_H;
        const float* src = logf + ((size_t)b * SEQ + lane * 64) * FOX_H + h;
        float s = 0.f;
        for (int i = 0; i < 64; ++i) s += src[(size_t)i * FOX_H];
        float inc = s;
#pragma unroll
        for (int o = 1; o < 64; o <<= 1) { const float t = __shfl_up(inc, o); if (lane >= o) inc += t; }
        float run = inc - s;
        float* dst = dcum + (size_t)q * SEQ + lane * 64;
        for (int i = 0; i < 64; ++i) { run += src[(size_t)i * FOX_H]; dst[i] = run; }
    }
}

struct NAttn { const bf16* Q; int qpitch; const bf16* K; const bf16* V; int kvpitch; bf16* O; int opitch; const float* dcum; int nheads; int sq; int skv; float scale; };
template <int DH, bool CAUSAL>
__device__ __forceinline__ void nattn_unit(const NAttn& A, int b, int hh, int qt, LAS float* lds, int tid) {
    constexpr int LD = DH + 4, C8 = DH / 8, DS = DH / 8;
    LAS float* Qs = lds; LAS float* Ks = Qs + 64 * LD; LAS float* Vs = Ks + 64 * LD; LAS float* Ps = Vs + 64 * LD;
    const int r = tid >> 3, sub = tid & 7;
    const size_t qrow0 = (size_t)b * A.sq + qt * 64, krow0 = (size_t)b * A.skv;
    __syncthreads();
    for (int idx = tid; idx < 64 * C8; idx += NTHR) { const int row = idx / C8, c8 = idx % C8;
        const v4u w = *(const GAS v4u*)(A.Q + (qrow0 + row) * A.qpitch + hh * DH + c8 * 8);
        LAS float* d = Qs + row * LD + c8 * 8;
        d[0] = bf2f(w.x & 0xffff); d[1] = bf2f(w.x >> 16); d[2] = bf2f(w.y & 0xffff); d[3] = bf2f(w.y >> 16); d[4] = bf2f(w.z & 0xffff); d[5] = bf2f(w.z >> 16); d[6] = bf2f(w.w & 0xffff); d[7] = bf2f(w.w >> 16); }
    float m_run = -1e30f, l_run = 0.f, o[DS];
#pragma unroll
    for (int d = 0; d < DS; ++d) o[d] = 0.f;
    const int qpos = qt * 64 + r;
    float dq = 0.f; if (CAUSAL) dq = A.dcum[((size_t)b * A.nheads + hh) * A.skv + qpos];
    const int nkt = CAUSAL ? qt + 1 : A.skv / 64;
    for (int kt = 0; kt < nkt; ++kt) {
        __syncthreads();
        for (int idx = tid; idx < 64 * C8; idx += NTHR) { const int row = idx / C8, c8 = idx % C8;
            const v4u wk = *(const GAS v4u*)(A.K + (krow0 + kt * 64 + row) * A.kvpitch + hh * DH + c8 * 8);
            const v4u wv = *(const GAS v4u*)(A.V + (krow0 + kt * 64 + row) * A.kvpitch + hh * DH + c8 * 8);
            LAS float* d = Ks + row * LD + c8 * 8;
            d[0] = bf2f(wk.x & 0xffff); d[1] = bf2f(wk.x >> 16); d[2] = bf2f(wk.y & 0xffff); d[3] = bf2f(wk.y >> 16); d[4] = bf2f(wk.z & 0xffff); d[5] = bf2f(wk.z >> 16); d[6] = bf2f(wk.w & 0xffff); d[7] = bf2f(wk.w >> 16);
            LAS float* e = Vs + row * LD + c8 * 8;
            e[0] = bf2f(wv.x & 0xffff); e[1] = bf2f(wv.x >> 16); e[2] = bf2f(wv.y & 0xffff); e[3] = bf2f(wv.y >> 16); e[4] = bf2f(wv.z & 0xffff); e[5] = bf2f(wv.z >> 16); e[6] = bf2f(wv.w & 0xffff); e[7] = bf2f(wv.w >> 16); }
        __syncthreads();
        float s[8];
#pragma unroll
        for (int jj = 0; jj < 8; ++jj) s[jj] = 0.f;
        for (int d = 0; d < DH; d += 4) { const f32x4 q4 = *(const LAS f32x4*)(Qs + r * LD + d);
#pragma unroll
            for (int jj = 0; jj < 8; ++jj) { const f32x4 k4 = *(const LAS f32x4*)(Ks + (sub * 8 + jj) * LD + d); s[jj] += (q4.x * k4.x + q4.y * k4.y) + (q4.z * k4.z + q4.w * k4.w); } }
        float tmax = -__builtin_inff();
#pragma unroll
        for (int jj = 0; jj < 8; ++jj) { const int kpos = kt * 64 + sub * 8 + jj; float v = s[jj] * A.scale;
            if (CAUSAL) { v += dq - A.dcum[((size_t)b * A.nheads + hh) * A.skv + kpos]; if (kpos > qpos) v = -__builtin_inff(); }
            s[jj] = v; tmax = fmaxf(tmax, v); }
        tmax = fmaxf(tmax, __shfl_xor(tmax, 1)); tmax = fmaxf(tmax, __shfl_xor(tmax, 2)); tmax = fmaxf(tmax, __shfl_xor(tmax, 4));
        const float m_new = fmaxf(m_run, tmax), alpha = __expf(m_run - m_new);
        float ps = 0.f;
#pragma unroll
        for (int jj = 0; jj < 8; ++jj) { const float p = __expf(s[jj] - m_new); ps += p; Ps[r * 68 + sub * 8 + jj] = p; }
        ps += __shfl_xor(ps, 1); ps += __shfl_xor(ps, 2); ps += __shfl_xor(ps, 4);
        l_run = l_run * alpha + ps; m_run = m_new;
#pragma unroll
        for (int d = 0; d < DS; ++d) o[d] *= alpha;
        __syncthreads();
        for (int j = 0; j < 64; ++j) { const float p = Ps[r * 68 + j];
#pragma unroll
            for (int d = 0; d < DS; d += 4) { const f32x4 v4 = *(const LAS f32x4*)(Vs + j * LD + sub * DS + d); o[d] += p * v4.x; o[d + 1] += p * v4.y; o[d + 2] += p * v4.z; o[d + 3] += p * v4.w; } }
    }
    const float inv = 1.f / l_run;
    bf16* op = A.O + (qrow0 + r) * A.opitch + hh * DH + sub * DS;
#pragma unroll
    for (int d = 0; d < DS; d += 8) { v4u w; w.x = pk2(o[d] * inv, o[d + 1] * inv); w.y = pk2(o[d + 2] * inv, o[d + 3] * inv); w.z = pk2(o[d + 4] * inv, o[d + 5] * inv); w.w = pk2(o[d + 6] * inv, o[d + 7] * inv);
        *(GAS v4u*)(op + d) = w; }
}

struct NGla { const bf16* P; const float* wg; const float* bg; float* obuf; };
__device__ __forceinline__ void ngla_unit(const NGla& G, int b, int h, LAS float* lds, int tid) {
    constexpr int TB = 32;
    LAS float* Qs = lds; LAS float* Ks = Qs + TB * 96; LAS float* As = Ks + TB * 96; LAS float* Vs = As + TB * 96;
    LAS float* Gl = Vs + TB * 192; LAS float* Wg = Gl + TB * 16; LAS float* Bg = Wg + 16 * 96;
    float S[96];
#pragma unroll
    for (int d = 0; d < 96; ++d) S[d] = 0.f;
    __syncthreads();
    for (int idx = tid; idx < 16 * 96; idx += NTHR) Wg[idx] = G.wg[(idx / 96) * GLA_DK + h * 96 + idx % 96];
    if (tid < 96) Bg[tid] = G.bg[h * 96 + tid];
    for (int c = 0; c < SEQ / TB; ++c) {
        const size_t row0 = (size_t)b * SEQ + c * TB;
        __syncthreads();
        for (int idx = tid; idx < TB * 16; idx += NTHR) Gl[idx] = bf2f(G.P[(row0 + idx / 16) * NA + PA_GL + idx % 16]);
        for (int idx = tid; idx < TB * 96; idx += NTHR) { const int t = idx / 96, d = idx % 96;
            Qs[idx] = bf2f(G.P[(row0 + t) * NA + PA_Q + h * 96 + d]); Ks[idx] = bf2f(G.P[(row0 + t) * NA + PA_K + h * 96 + d]); }
        for (int idx = tid; idx < TB * 192; idx += NTHR) { const int t = idx / 192, e = idx % 192; Vs[idx] = bf2f(G.P[(row0 + t) * NA + PA_V + h * 192 + e]); }
        __syncthreads();
        for (int idx = tid; idx < TB * 96; idx += NTHR) { const int t = idx / 96, d = idx % 96; float z = Bg[d];
#pragma unroll
            for (int r = 0; r < 16; ++r) z += Gl[t * 16 + r] * Wg[r * 96 + d];
            As[idx] = expf(log_sigmoid_f(z) * (1.0f / 16.0f)); }
        __syncthreads();
        if (tid < 192) {
            for (int t = 0; t < TB; ++t) { const float vt = Vs[t * 192 + tid]; float o = 0.f;
#pragma unroll
                for (int d = 0; d < 96; d += 4) { const f32x4 a4 = *(const LAS f32x4*)(As + t * 96 + d), k4 = *(const LAS f32x4*)(Ks + t * 96 + d), q4 = *(const LAS f32x4*)(Qs + t * 96 + d);
                    S[d] = a4.x * S[d] + k4.x * vt; S[d + 1] = a4.y * S[d + 1] + k4.y * vt; S[d + 2] = a4.z * S[d + 2] + k4.z * vt; S[d + 3] = a4.w * S[d + 3] + k4.w * vt;
                    o += (q4.x * S[d] + q4.y * S[d + 1]) + (q4.z * S[d + 2] + q4.w * S[d + 3]); }
                G.obuf[(row0 + t) * GLA_DV + h * 192 + tid] = o; }
        }
    }
}
__device__ __forceinline__ void gla_post_phase(const float* obuf, const bf16* P, const float* ghead, bf16* mix, int gw, int NGW, int lane) {
    for (int it = gw; it < M * GLA_H; it += NGW) { const int row = it >> 2, h = it & 3;
        const float* o = obuf + (size_t)row * GLA_DV + h * 192; float v[3]; float s = 0.f;
#pragma unroll
        for (int j = 0; j < 3; ++j) { v[j] = o[lane + 64 * j]; s += v[j] * v[j]; }
        const float rstd = 1.0f / sqrtf(wave_sum(s) * (1.f / 192.f) + EPS);
#pragma unroll
        for (int j = 0; j < 3; ++j) { const int e = lane + 64 * j; const float r = bf2f(P[(size_t)row * NA + PA_R + h * 192 + e]);
            const float y = v[j] * rstd * ghead[e]; const float sg = r / (1.0f + expf(-r));
            mix[(size_t)row * DM + h * 192 + e] = (bf16)f2bf(y * sg); }
    }
}
#ifndef SITE_MASK
#define SITE_MASK 0xffffffffu
#endif
struct Args { const float* in[19]; float* out; unsigned char* ws; int ph_lo, ph_hi, onelaunch, pad; };
constexpr int I_W1 = (DM / 64) * (NFF1 / 32), I_W2 = (DFF / 64) * (DM / 32), I_WA = (DM / 64) * (NA / 32), I_WB = (DM / 64) * (NB / 32), I_WO = (DM / 64) * (DM / 32), I_WKV = (DM / 64) * (NKV / 32), I_WM1 = (DM / 64) * (512 / 32);
constexpr int NITEMS = 8 * I_W1 + 8 * I_W2 + 2 * I_WA + 2 * I_WB + 4 * I_WO + I_WKV + 4 * I_WM1;

template <int OFF> __device__ __forceinline__ unsigned long long karg_u64() {
    unsigned long long v;
    asm volatile("s_load_dwordx2 %0, %1, %2\n\ts_waitcnt lgkmcnt(0)" : "=s"(v) : "s"(__builtin_amdgcn_kernarg_segment_ptr()), "i"(OFF) : "memory");
    return v;
}
#define IN_PTR(i) ((const float*)karg_u64<8 * (i)>())
#define OUT_PTR() ((float*)karg_u64<8 * 19>())
#define WS_PTR() ((unsigned char*)karg_u64<8 * 20>())
#define WSP(T, off) ((T*)(WS_PTR() + (off)))
__global__ void __launch_bounds__(NTHR, 2) yoco_fwd(Args args) {
    extern __shared__ __attribute__((aligned(16))) unsigned char lds_raw[];
    LAS unsigned char* lds = (LAS unsigned char*)lds_raw;
    for (int u = threadIdx.x; u < (LDS_BYTES - LDSCTL_OFF) / 4; u += NTHR) ((LAS unsigned*)(lds + LDSCTL_OFF))[u] = 0u;
    __syncthreads();
    if (args.onelaunch) (void)xcd_barrier_post((unsigned*)(WSP(unsigned, WS_CTL) + CW_BAR), (volatile LAS unsigned*)(lds + MISC_OFF) + 8);
#define TID tid_
#define LANE (tid_ & 63)
#define WAVE (__builtin_amdgcn_readfirstlane(tid_ >> 6))
#define GRID ((int)gridDim.x)
#define BX bx_
#define VCU ((GRID % 8 == 0) ? (BX % 8) * (GRID / 8) + BX / 8 : BX)
#define GW (VCU * NWAVES + WAVE)
#define NGW_ (GRID * NWAVES)
    const int lo = args.ph_lo, hi = args.ph_hi;
    int ph = 0;
#define PH_BEGIN if (ph >= lo && ph < hi) { int tid_ = threadIdx.x; asm volatile("" : "+v"(tid_)); int bx_ = blockIdx.x; asm volatile("" : "+s"(bx_));
#define PH_END   if (ph + 1 < hi) { XcdBarrier bar_; bar_.bar = (unsigned*)(WSP(unsigned, WS_CTL) + CW_BAR); bar_.x = xb_xcc_id(); bar_.st = (volatile LAS unsigned*)(lds + MISC_OFF) + 8; xcd_barrier(bar_); } } ++ph;

    PH_BEGIN if (SITE_MASK & (1u << 0)) {
        LAS float* scr = (LAS float*)(lds + RING_OFF + WAVE * 16384);
        for (int it = GW; it < NITEMS; it += NGW_) {
            int r = it;
            if (r < 8 * I_W1) { const int mat = r / I_W1; transpose_item(IN_PTR(3) + (size_t)mat * DM * NFF1, DM, NFF1, NFF1, WSP(bf16, WS_W1) + (size_t)mat * NFF1 * DM, scr, r % I_W1, LANE, nullptr, MapSwi()); continue; } r -= 8 * I_W1;
            if (r < 8 * I_W2) { const int mat = r / I_W2; transpose_item(IN_PTR(4) + (size_t)mat * DFF * DM, DFF, DM, DM, WSP(bf16, WS_W2) + (size_t)mat * DM * DFF, scr, r % I_W2, LANE, nullptr, MapPlain()); continue; } r -= 8 * I_W2;
            if (r < 2 * I_WA) { const int mat = r / I_WA; transpose_item(IN_PTR(9) + (size_t)mat * DM * A_IN_W, DM, A_IN_W, NA, WSP(bf16, WS_WA) + (size_t)mat * NA * DM, scr, r % I_WA, LANE, nullptr, MapInA()); continue; } r -= 2 * I_WA;
            if (r < 2 * I_WB) { const int mat = r / I_WB; transpose_item(IN_PTR(13) + (size_t)mat * DM * NB, DM, NB, NB, WSP(bf16, WS_WB) + (size_t)mat * NB * DM, scr, r % I_WB, LANE, nullptr, MapInB()); continue; } r -= 2 * I_WB;
            if (r < 4 * I_WO) { const int mat = r / I_WO; transpose_item(IN_PTR(8) + (size_t)mat * DM * DM, DM, DM, DM, WSP(bf16, WS_WO) + (size_t)mat * DM * DM, scr, r % I_WO, LANE, nullptr, MapPlain()); continue; } r -= 4 * I_WO;
            if (r < I_WKV) { transpose_item(IN_PTR(15), DM, NKV, NKV, WSP(bf16, WS_WKV), scr, r, LANE, nullptr, MapPlain()); continue; } r -= I_WKV;
            { const int mat = r / I_WM1; transpose_item(IN_PTR(7) + (size_t)mat * DM * 512, DM, 512, 512, WSP(bf16, WS_WM) + (size_t)mat * 512 * DM, scr, r % I_WM1, LANE, IN_PTR(6) + mat * DM, MapPlain()); }
        }
        { const NormArgs a{IN_PTR(1), nullptr, WSP(bf16, WS_MEMN), nullptr, nullptr, nullptr, nullptr, nullptr, MEMROWS, 8}; norm_phase(a, GW, NGW_, LANE); }
        { const NormArgs a{IN_PTR(0), IN_PTR(2), WSP(bf16, WS_XN), OUT_PTR(), nullptr, nullptr, nullptr, nullptr, M, 1}; norm_phase(a, GW, NGW_, LANE); }
    } PH_END

    PH_BEGIN if (SITE_MASK & (1u << 1)) {
        pg8::Gemm g{WSP(bf16, WS_MEMN), WSP(bf16, WS_WM), MEMROWS, NMEMKV, DM}; pg8::StaticOrder S; S.init(MEMROWS, NMEMKV, GRID, BX);
        pg8::EpiBf16 E{WSP(bf16, WS_MEMKV), NMEMKV};
        pg8::gemm_phase<pg8::EpiBf16, pg8::StaticOrder, true, true>(lds + RING_OFF, g, S, E);
    } PH_END

    for (int l = 0; l < DEPTH; ++l) {
        for (int hf = 0; hf < 2; ++hf) {
            if (hf == 1) {
                PH_BEGIN if (SITE_MASK & (1u << 2)) {
                    const bool gla = l < 2; const int N = gla ? NA : NB;
                    pg8::Gemm g{WSP(bf16, WS_XN), gla ? WSP(bf16, WS_WA) + (size_t)l * NA * DM : WSP(bf16, WS_WB) + (size_t)(l - 2) * NB * DM, M, N, DM}; pg8::StaticOrder S; S.init(M, N, GRID, BX);
                    pg8::EpiBf16 E{WSP(bf16, WS_R2), N};
                    pg8::gemm_phase<pg8::EpiBf16, pg8::StaticOrder, true, true>(lds + RING_OFF, g, S, E);
                } PH_END
                if (l < 2) {
                    PH_BEGIN if (SITE_MASK & (1u << 3)) {
                        const NAttn A{WSP(bf16, WS_R2) + PA_QM, NA, WSP(bf16, WS_MEMKV) + l * 512, WSP(bf16, WS_MEMKV) + l * 512 + 256, NMEMKV, WSP(bf16, WS_XN) + MAIN_W, DM, nullptr, MEM_H, SEQ, MEM_LEN, 1.0f};
                        if (BX < BATCH * GLA_H) { const NGla Gp{WSP(bf16, WS_R2), IN_PTR(10) + (size_t)l * GLA_R * GLA_DK, IN_PTR(11) + l * GLA_DK, WSP(float, WS_R1)}; ngla_unit(Gp, BX >> 2, BX & 3, (LAS float*)lds, TID); }
                        else for (int u = BX - BATCH * GLA_H; u < BATCH * MEM_H * (SEQ / 64); u += GRID - BATCH * GLA_H) nattn_unit<MEM_DH, false>(A, u / (MEM_H * (SEQ / 64)), (u / (SEQ / 64)) % MEM_H, u % (SEQ / 64), (LAS float*)lds, TID);
                    } PH_END
                    PH_BEGIN if (SITE_MASK & (1u << 4)) {
                        gla_post_phase(WSP(float, WS_R1), WSP(bf16, WS_R2), IN_PTR(12) + l * GLA_DVH, WSP(bf16, WS_XN), GW, NGW_, LANE);
                    } PH_END
                } else {
                    PH_BEGIN if (SITE_MASK & (1u << 5)) {
                        const NAttn F{WSP(bf16, WS_R2), NB, WSP(bf16, WS_KV), WSP(bf16, WS_KV) + MAIN_W, NKV, WSP(bf16, WS_XN), DM, WSP(float, WS_SMALL + 1 * MiB), FOX_H, SEQ, SEQ, 0.08838834764831845f};
                        const NAttn A{WSP(bf16, WS_R2) + MAIN_W, NB, WSP(bf16, WS_MEMKV) + l * 512, WSP(bf16, WS_MEMKV) + l * 512 + 256, NMEMKV, WSP(bf16, WS_XN) + MAIN_W, DM, nullptr, MEM_H, SEQ, MEM_LEN, 1.0f};
                        constexpr int NFU = BATCH * FOX_H * (SEQ / 64), NMU = BATCH * MEM_H * (SEQ / 64);
                        for (int u = BX; u < NFU + NMU; u += GRID) {
                            if (u < NFU) { const int qt = SEQ / 64 - 1 - u / (BATCH * FOX_H), bh = u % (BATCH * FOX_H); nattn_unit<FOX_DH, true>(F, bh / FOX_H, bh % FOX_H, qt, (LAS float*)lds, TID); }
                            else { const int v = u - NFU; nattn_unit<MEM_DH, false>(A, v / (MEM_H * (SEQ / 64)), (v / (SEQ / 64)) % MEM_H, v % (SEQ / 64), (LAS float*)lds, TID); }
                        }
                    } PH_END
                }
                PH_BEGIN if (SITE_MASK & (1u << 6)) {
                    pg8::Gemm g{WSP(bf16, WS_XN), WSP(bf16, WS_WO) + (size_t)l * DM * DM, M, DM, DM}; pg8::StaticOrder S; S.init(M, DM, GRID, BX);
                    pg8::EpiResid E{OUT_PTR(), DM, 1.0f};
                    pg8::gemm_phase<pg8::EpiResid, pg8::StaticOrder, true, true>(lds + RING_OFF, g, S, E);
                } PH_END
                PH_BEGIN if (SITE_MASK & (1u << 7)) {
                    const NormArgs a{OUT_PTR(), IN_PTR(2) + (size_t)(l * 2 + 1) * DM, WSP(bf16, WS_XN), nullptr, nullptr, nullptr, nullptr, nullptr, M, 0}; norm_phase(a, GW, NGW_, LANE);
                } PH_END
            }
            PH_BEGIN if (SITE_MASK & (1u << 8)) {
                pg8::Gemm g{WSP(bf16, WS_XN), WSP(bf16, WS_W1) + (size_t)(l * 2 + hf) * NFF1 * DM, M, NFF1, DM}; pg8::StaticOrder S; S.init(M, NFF1, GRID, BX);
                pg8::EpiSwiGLU E{WSP(bf16, WS_R1), DFF};
                pg8::gemm_phase<pg8::EpiSwiGLU, pg8::StaticOrder, true, true>(lds + RING_OFF, g, S, E);
            } PH_END
            PH_BEGIN if (SITE_MASK & (1u << 9)) {
                pg8::Gemm g{WSP(bf16, WS_R1), WSP(bf16, WS_W2) + (size_t)(l * 2 + hf) * DM * DFF, M, DM, DFF}; pg8::StaticOrder S; S.init(M, DM, GRID, BX);
                pg8::EpiResid E{OUT_PTR(), DM, 0.5f};
                pg8::gemm_phase<pg8::EpiResid, pg8::StaticOrder, true, true>(lds + RING_OFF, g, S, E);
            } PH_END
            if (hf == 0) {
                PH_BEGIN if (SITE_MASK & (1u << 10)) {
                    const NormArgs a{OUT_PTR(), IN_PTR(5) + (size_t)l * DM, WSP(bf16, WS_XN), nullptr, nullptr, nullptr, nullptr, nullptr, M, 0}; norm_phase(a, GW, NGW_, LANE);
                } PH_END
            } else {
                if (l == 1) {
                    PH_BEGIN if (SITE_MASK & (1u << 11)) {
                        const NormArgs a{OUT_PTR(), IN_PTR(14), WSP(bf16, WS_XN), nullptr, nullptr, IN_PTR(16), IN_PTR(17), WSP(float, WS_SMALL), M, 4}; norm_phase(a, GW, NGW_, LANE);
                    } PH_END
                    PH_BEGIN if (SITE_MASK & (1u << 12)) {
                        dcum_phase(WSP(float, WS_SMALL), WSP(float, WS_SMALL + 1 * MiB), GW, NGW_, LANE);
                        pg8::Gemm g{WSP(bf16, WS_XN), WSP(bf16, WS_WKV), M, NKV, DM}; pg8::StaticOrder S; S.init(M, NKV, GRID, BX);
                        pg8::EpiBf16 E{WSP(bf16, WS_KV), NKV};
                        pg8::gemm_phase<pg8::EpiBf16, pg8::StaticOrder, true, true>(lds + RING_OFF, g, S, E);
                    } PH_END
                }
                PH_BEGIN if (SITE_MASK & (1u << 13)) {
                    if (l < DEPTH - 1) { const NormArgs a{OUT_PTR(), IN_PTR(2) + (size_t)((l + 1) * 2) * DM, WSP(bf16, WS_XN), nullptr, nullptr, nullptr, nullptr, nullptr, M, 0}; norm_phase(a, GW, NGW_, LANE); }
                    else { const NormArgs a{OUT_PTR(), IN_PTR(18), nullptr, nullptr, OUT_PTR(), nullptr, nullptr, nullptr, M, 2}; norm_phase(a, GW, NGW_, LANE); }
                } PH_END
            }
        }
    }
#undef PH_BEGIN if (SITE_MASK & (1u << 14)) {
#undef PH_END
}

static int count_phases() { int n = 2; for (int l = 0; l < DEPTH; ++l) n += 11 + (l < 2 ? 1 : 0) + (l == 1 ? 2 : 0); return n; }
#ifndef ONE_LAUNCH
#define ONE_LAUNCH 0
#endif
extern "C" void kernel_launch(void* const* d_in, const int* in_sizes, int n_in, void* d_out, int out_size, void* d_ws, size_t ws_size, hipStream_t stream) {
    static int grid = 0;
    if (grid == 0) {
        if (n_in != 19 || in_sizes[0] != M * DM || out_size != M * DM || ws_size < WS_END) { fprintf(stderr, "kernel_launch: unexpected shapes (n_in %d, in0 %d, out %d, ws %zu < %zu); nothing launched\n", n_in, n_in > 0 ? in_sizes[0] : -1, out_size, ws_size, (size_t)WS_END); grid = -1; return; }
        int dev = 0, cus = 0, per_cu = 0;
        if (hipGetDevice(&dev) != hipSuccess || hipDeviceGetAttribute(&cus, hipDeviceAttributeMultiprocessorCount, dev) != hipSuccess) { grid = -1; return; }
        if (hipFuncSetAttribute((const void*)yoco_fwd, hipFuncAttributeMaxDynamicSharedMemorySize, LDS_BYTES) != hipSuccess) { fprintf(stderr, "kernel_launch: hipFuncSetAttribute failed\n"); grid = -1; return; }
        if (hipOccupancyMaxActiveBlocksPerMultiprocessor(&per_cu, (const void*)yoco_fwd, NTHR, LDS_BYTES) != hipSuccess || per_cu < 1) fprintf(stderr, "kernel_launch: occupancy query reports %d\n", per_cu);
        (void)hipGetLastError();
        grid = cus;
    }
    if (grid < 0) return;
    if (hipMemsetAsync((char*)d_ws + WS_CTL, 0, CTL_ZERO_BYTES, stream) != hipSuccess) return;
    Args a{};
    for (int i = 0; i < 19; ++i) a.in[i] = (const float*)d_in[i];
    a.out = (float*)d_out; a.ws = (unsigned char*)d_ws; a.pad = 0;
    const int nph = count_phases();
    if (ONE_LAUNCH) { a.ph_lo = 0; a.ph_hi = nph; a.onelaunch = 1; hipLaunchKernelGGL(yoco_fwd, dim3(grid), dim3(NTHR), LDS_BYTES, stream, a); }
    else for (int p = 0; p < nph; ++p) { a.ph_lo = p; a.ph_hi = p + 1; a.onelaunch = 0; hipLaunchKernelGGL(yoco_fwd, dim3(grid), dim3(NTHR), LDS_BYTES, stream, a); }
}
```

```cpp
#include <hip/hip_runtime.h>
#include <cstdio>
#include <cstdint>
#include <cmath>
namespace pg8 {
#define PG8_LAS __attribute__((address_space(3)))
typedef unsigned short bf16_t;
typedef short bf16x8 __attribute__((ext_vector_type(8)));
typedef float f32x4 __attribute__((ext_vector_type(4)));
typedef unsigned u32x4 __attribute__((ext_vector_type(4)));
constexpr int BM = 256, BK = 64, HALF = 128, HTB = HALF * BK * 2  , STAGE_BYTES = 8 * HTB, NXCD = 8, WGM = 4;

__host__ __device__ __forceinline__ int lds_byte(int r, int c) { const int st = (r >> 4) * 2 + (c >> 5), rr = r & 15, cc = c & 31, ob = rr * 64 + cc * 2; return st * 1024 + (ob ^ (((ob >> 9) & 1) << 5)); }
__host__ __device__ __forceinline__ void stage_rc(int b, int& R, int& C) { const int st = b / 1024, sb = b % 1024, swz = sb ^ (((sb >> 9) & 1) << 5); R = (st >> 1) * 16 + swz / 64; C = (st & 1) * 32 + (swz % 64) / 2; }
__host__ __device__ __forceinline__ int perm32(int rho) { const int n = rho >> 4, i = rho & 15; return 8 * (i >> 2) + 4 * n + (i & 3); }

struct Unit { int pm, pn; };
struct Gemm { const bf16_t* A; const bf16_t* Bt; int M, N, K; };

struct StaticOrder {
    int nM, nN, nwg, G, c;
    __host__ __device__ void init(int M, int N, int G_, int c_) { nM = M / BM; nN = N / BM; nwg = nM * nN; G = G_; c = c_; }
    __host__ __device__ bool next(int i, Unit& u) const {
        const long L = (long)i * G + c; if (L >= nwg) return false;
        int wgid = (int)L; { const int q = nwg / NXCD, r = nwg % NXCD, xcd = wgid % NXCD, off = wgid / NXCD; wgid = (xcd < r ? xcd * (q + 1) : r * (q + 1) + (xcd - r) * q) + off; }
        const int nig = WGM * nN, gid = wgid / nig, fm = gid * WGM, gsz = (nM - fm) < WGM ? (nM - fm) : WGM;
        u.pm = fm + ((wgid % nig) % gsz); u.pn = (wgid % nig) / gsz; return true;
    }
    __device__ __forceinline__ void a_ready(const Unit&) const {}
    __device__ __forceinline__ void done(const Unit&) const {}
};

__device__ __forceinline__ unsigned cvt_pk_bf16(float lo, float hi) { unsigned r; asm volatile("v_cvt_pk_bf16_f32 %0, %1, %2" : "=v"(r) : "v"(lo), "v"(hi)); return r; }
typedef float f32x2 __attribute__((ext_vector_type(2)));
__device__ __forceinline__ float silu_f(float a) { return a * __builtin_amdgcn_rcpf(1.0f + __builtin_amdgcn_exp2f(-1.4426950408889634f * a)); }
struct EpiBf16 {
    static constexpr bool PERM = true, AFTER_DRAIN = false;
    bf16_t* O; int ldc; const unsigned long long* ss;
    float* n2; int n2_tiles, n2_rows; int ncol;
    __device__ __forceinline__ void operator()(const f32x4 (&acc)[2][2][4][2], const Unit& u, int wr, int wc, int fr, int fq) const {
        const int row0 = u.pm * BM + wr * 64 + fr, col0 = u.pn * BM + wc * 32 + 8 * fq;
        float rsv[2][4];
#pragma unroll
        for (int ai = 0; ai < 2; ++ai)
#pragma unroll
            for (int m = 0; m < 4; ++m) rsv[ai][m] = 1.0f;
        if (ss) { unsigned long long sv[2][4];
#pragma unroll
            for (int ai = 0; ai < 2; ++ai)
#pragma unroll
                for (int m = 0; m < 4; ++m) sv[ai][m] = ss[row0 + ai * HALF + m * 16];
#pragma unroll
            for (int ai = 0; ai < 2; ++ai)
#pragma unroll
                for (int m = 0; m < 4; ++m) rsv[ai][m] = __builtin_amdgcn_rsqf((float)sv[ai][m] * (1.0f / (1024.0f * 4294967296.0f)) + 1e-6f); }
#pragma unroll
        for (int ai = 0; ai < 2; ++ai)
#pragma unroll
            for (int m = 0; m < 4; ++m) { bf16_t* rowp = O + (size_t)(row0 + ai * HALF + m * 16) * ldc + col0;
                const float rs = rsv[ai][m];
#pragma unroll
                for (int bj = 0; bj < 2; ++bj) { const f32x4 v0 = acc[ai][bj][m][0] * rs, v1 = acc[ai][bj][m][1] * rs;
                    u32x4 w; w.x = cvt_pk_bf16(v0[0], v0[1]); w.y = cvt_pk_bf16(v0[2], v0[3]); w.z = cvt_pk_bf16(v1[0], v1[1]); w.w = cvt_pk_bf16(v1[2], v1[3]);
                    if (ncol == 0 || col0 + bj * HALF < ncol) *(u32x4*)(rowp + bj * HALF) = w;
                    if (n2 && u.pn < n2_tiles) { float sq = ((v0[0] * v0[0] + v0[1] * v0[1]) + (v0[2] * v0[2] + v0[3] * v0[3])) + ((v1[0] * v1[0] + v1[1] * v1[1]) + (v1[2] * v1[2] + v1[3] * v1[3]));
                        { const auto r = __builtin_amdgcn_permlane16_swap(__float_as_uint(sq), __float_as_uint(sq), false, false); const unsigned ra = r[0], rb = r[1]; sq = __uint_as_float(ra) + __uint_as_float(rb); }
                        { const auto r = __builtin_amdgcn_permlane32_swap(__float_as_uint(sq), __float_as_uint(sq), false, false); const unsigned ra = r[0], rb = r[1]; sq = __uint_as_float(ra) + __uint_as_float(rb); }
                        if (fq == 0) atomicAdd(n2 + (size_t)(2 * u.pn + bj) * n2_rows + row0 + ai * HALF + m * 16, sq); } } }
    }
};
struct EpiSwiGLU {
    static constexpr bool PERM = true, AFTER_DRAIN = false;
    bf16_t* O; int ldc; const unsigned long long* ss;
    __device__ __forceinline__ void operator()(const f32x4 (&acc)[2][2][4][2], const Unit& u, int wr, int wc, int fr, int fq) const {
        const int row0 = u.pm * BM + wr * 64 + fr, col0 = u.pn * HALF + wc * 32 + 8 * fq;
        float rsv[2][4];
        { unsigned long long sv[2][4];
#pragma unroll
            for (int ai = 0; ai < 2; ++ai)
#pragma unroll
                for (int m = 0; m < 4; ++m) sv[ai][m] = ss[row0 + ai * HALF + m * 16];
#pragma unroll
            for (int ai = 0; ai < 2; ++ai)
#pragma unroll
                for (int m = 0; m < 4; ++m) rsv[ai][m] = __builtin_amdgcn_rsqf((float)sv[ai][m] * (1.0f / (1024.0f * 4294967296.0f)) + 1e-6f); }
#pragma unroll
        for (int ai = 0; ai < 2; ++ai)
#pragma unroll
            for (int m = 0; m < 4; ++m) { bf16_t* rowp = O + (size_t)(row0 + ai * HALF + m * 16) * ldc + col0;
                const float rs = rsv[ai][m], r2 = rs * -1.4426950408889634f, rr = rs * rs;
                const f32x4 A0 = acc[ai][0][m][0], A1 = acc[ai][0][m][1], C0 = acc[ai][1][m][0], C1 = acc[ai][1][m][1];
                const f32x4 t0 = A0 * r2, t1 = A1 * r2; f32x4 e0, e1, s0, s1;
#pragma unroll
                for (int e = 0; e < 4; ++e) { e0[e] = __builtin_amdgcn_exp2f(t0[e]); e1[e] = __builtin_amdgcn_exp2f(t1[e]); }
                const f32x4 d0 = e0 + 1.0f, d1 = e1 + 1.0f;
#pragma unroll
                for (int e = 0; e < 4; ++e) { s0[e] = __builtin_amdgcn_rcpf(d0[e]); s1[e] = __builtin_amdgcn_rcpf(d1[e]); }
                const f32x4 y0 = ((A0 * C0) * rr) * s0, y1 = ((A1 * C1) * rr) * s1;
                u32x4 w; w.x = cvt_pk_bf16(y0[0], y0[1]); w.y = cvt_pk_bf16(y0[2], y0[3]); w.z = cvt_pk_bf16(y1[0], y1[1]); w.w = cvt_pk_bf16(y1[2], y1[3]);
                *(u32x4*)rowp = w; }
    }
};
typedef unsigned u32x2 __attribute__((ext_vector_type(2)));
#define PG8_T24_DEC(hwd, lwd, k) __builtin_bit_cast(float, __builtin_amdgcn_perm((hwd), (lwd), (((5u + 2u * ((k) & 1u)) << 24) | ((4u + 2u * ((k) & 1u)) << 16) | (((k) & 3u) << 8) | 0x0cu)))
#ifndef STREAM16
#define STREAM16 1
#endif
struct EpiResidT24 {
    static constexpr bool PERM = true, AFTER_DRAIN = false;
    bf16_t* HI; unsigned char* LO; int ldc; float scale; unsigned long long* ss;
    __device__ __forceinline__ void operator()(const f32x4 (&acc)[2][2][4][2], const Unit& u, int wr, int wc, int fr, int fq) const {
        const int row0 = u.pm * BM + wr * 64 + fr, col0 = u.pn * BM + wc * 64 + 16 * fq;
#if STREAM16
#pragma unroll
        for (int ai = 0; ai < 2; ++ai) {
            u32x4 hw[4][2];
#pragma unroll
            for (int m = 0; m < 4; ++m) { const size_t off = (size_t)(row0 + ai * HALF + m * 16) * ldc + col0; hw[m][0] = *(const u32x4*)(HI + off); hw[m][1] = *(const u32x4*)(HI + off + 8); }
            asm volatile("" ::: "memory");
#pragma unroll
            for (int m = 0; m < 4; ++m) { const size_t off = (size_t)(row0 + ai * HALF + m * 16) * ldc + col0; f32x2 sq2 = {0.f, 0.f};
#pragma unroll
                for (int bj = 0; bj < 2; ++bj) { const u32x4 hw_ = hw[m][bj]; const f32x4 a0 = acc[ai][bj][m][0], a1 = acc[ai][bj][m][1]; u32x4 ho;
#define PG8_BLO(w_) __builtin_bit_cast(float, (w_) << 16)
#define PG8_BHI(w_) __builtin_bit_cast(float, (w_) & 0xffff0000u)
                    const f32x2 v0 = (f32x2){a0[0], a0[1]} * scale + (f32x2){PG8_BLO(hw_.x), PG8_BHI(hw_.x)}, v1 = (f32x2){a0[2], a0[3]} * scale + (f32x2){PG8_BLO(hw_.y), PG8_BHI(hw_.y)};
                    const f32x2 v2 = (f32x2){a1[0], a1[1]} * scale + (f32x2){PG8_BLO(hw_.z), PG8_BHI(hw_.z)}, v3 = (f32x2){a1[2], a1[3]} * scale + (f32x2){PG8_BLO(hw_.w), PG8_BHI(hw_.w)};
                    ho.x = cvt_pk_bf16(v0[0], v0[1]); ho.y = cvt_pk_bf16(v1[0], v1[1]); ho.z = cvt_pk_bf16(v2[0], v2[1]); ho.w = cvt_pk_bf16(v3[0], v3[1]);
                    *(u32x4*)(HI + off + 8 * bj) = ho;
                    sq2 += v0 * v0; sq2 += v1 * v1; sq2 += v2 * v2; sq2 += v3 * v3; }
                if (ss) { float sq = sq2[0] + sq2[1];
                    { const auto r = __builtin_amdgcn_permlane16_swap(__float_as_uint(sq), __float_as_uint(sq), false, false); const unsigned ra = r[0], rb = r[1]; sq = __uint_as_float(ra) + __uint_as_float(rb); }
                    { const auto r = __builtin_amdgcn_permlane32_swap(__float_as_uint(sq), __float_as_uint(sq), false, false); const unsigned ra = r[0], rb = r[1]; sq = __uint_as_float(ra) + __uint_as_float(rb); }
                    if (fq == 0) atomicAdd(ss + row0 + ai * HALF + m * 16, (unsigned long long)(sq * 4294967296.0f)); } }
            asm volatile("" ::: "memory");
        }
#else
#pragma unroll
        for (int ai = 0; ai < 2; ++ai) {
            u32x4 hw[4][2]; u32x4 lw[4];
#pragma unroll
            for (int m = 0; m < 4; ++m) { const size_t off = (size_t)(row0 + ai * HALF + m * 16) * ldc + col0; hw[m][0] = *(const u32x4*)(HI + off); hw[m][1] = *(const u32x4*)(HI + off + 8); lw[m] = *(const u32x4*)(LO + off); }
            asm volatile("" ::: "memory");
#pragma unroll
            for (int m = 0; m < 4; ++m) { const size_t off = (size_t)(row0 + ai * HALF + m * 16) * ldc + col0; float sq = 0.f; u32x4 lo_;
#pragma unroll
                for (int bj = 0; bj < 2; ++bj) { const u32x4 hw_ = hw[m][bj]; const unsigned l0 = bj ? lw[m].z : lw[m].x, l1 = bj ? lw[m].w : lw[m].y;
                    const f32x4 d0 = acc[ai][bj][m][0] * scale, d1 = acc[ai][bj][m][1] * scale; unsigned w[8];
                    w[0] = __builtin_bit_cast(unsigned, PG8_T24_DEC(hw_.x, l0, 0u) + d0[0]) + 0x80u; w[1] = __builtin_bit_cast(unsigned, PG8_T24_DEC(hw_.x, l0, 1u) + d0[1]) + 0x80u;
                    w[2] = __builtin_bit_cast(unsigned, PG8_T24_DEC(hw_.y, l0, 2u) + d0[2]) + 0x80u; w[3] = __builtin_bit_cast(unsigned, PG8_T24_DEC(hw_.y, l0, 3u) + d0[3]) + 0x80u;
                    w[4] = __builtin_bit_cast(unsigned, PG8_T24_DEC(hw_.z, l1, 0u) + d1[0]) + 0x80u; w[5] = __builtin_bit_cast(unsigned, PG8_T24_DEC(hw_.z, l1, 1u) + d1[1]) + 0x80u;
                    w[6] = __builtin_bit_cast(unsigned, PG8_T24_DEC(hw_.w, l1, 2u) + d1[2]) + 0x80u; w[7] = __builtin_bit_cast(unsigned, PG8_T24_DEC(hw_.w, l1, 3u) + d1[3]) + 0x80u;
                    u32x4 ho;
                    ho.x = __builtin_amdgcn_perm(w[1], w[0], 0x07060302u); ho.y = __builtin_amdgcn_perm(w[3], w[2], 0x07060302u); ho.z = __builtin_amdgcn_perm(w[5], w[4], 0x07060302u); ho.w = __builtin_amdgcn_perm(w[7], w[6], 0x07060302u);
                    const unsigned la = __builtin_amdgcn_perm(w[1], w[0], 0x0c0c0501u) | (__builtin_amdgcn_perm(w[3], w[2], 0x0c0c0501u) << 16), lb = __builtin_amdgcn_perm(w[5], w[4], 0x0c0c0501u) | (__builtin_amdgcn_perm(w[7], w[6], 0x0c0c0501u) << 16);
                    if (bj == 0) { lo_.x = la; lo_.y = lb; } else { lo_.z = la; lo_.w = lb; }
                    *(u32x4*)(HI + off + 8 * bj) = ho;
#pragma unroll
                    for (int k = 0; k < 8; ++k) { const float t = __builtin_bit_cast(float, w[k] & 0xffff0000u); sq += t * t; } }
                *(u32x4*)(LO + off) = lo_;
                if (ss) { sq += __shfl_xor(sq, 16); sq += __shfl_xor(sq, 32); if (fq == 0) atomicAdd(ss + row0 + ai * HALF + m * 16, (unsigned long long)(sq * 4294967296.0f)); } }
            asm volatile("" ::: "memory");
        }
#endif
    }
};
struct EpiNull {
    static constexpr bool PERM = true, AFTER_DRAIN = false;
    __device__ __forceinline__ void operator()(const f32x4 (&acc)[2][2][4][2], const Unit& u, int wr, int wc, int fr, int fq) const {
#pragma unroll
        for (int ai = 0; ai < 2; ++ai)
#pragma unroll
            for (int bj = 0; bj < 2; ++bj)
#pragma unroll
                for (int m = 0; m < 4; ++m) asm volatile("" :: "v"(acc[ai][bj][m][0]), "v"(acc[ai][bj][m][1]));
    }
};
template <class Epi, class Sched, bool ALIGN_EPI = false, bool SP2 = false, int KC = 0  >
__device__ __forceinline__ void gemm_phase(PG8_LAS unsigned char* lds, const Gemm g, const Sched& S, const Epi& E, const int tid_in  ) {
    int tid_o = tid_in; asm volatile("" : "+v"(tid_o));
    const int tid = tid_o, wid = __builtin_amdgcn_readfirstlane(tid >> 6), lane = tid & 63, wr = wid >> 2, wc = wid & 3, fr = lane & 15, fq = lane >> 4;
    const int K = KC ? KC : g.K, nt = K / BK;
    unsigned voffA[2], voffB[2];
#pragma unroll
    for (int i = 0; i < 2; ++i) { int R, C; stage_rc(tid * 16 + i * 8192, R, C); const int Rb = Epi::PERM ? ((R & ~31) + perm32(R & 31)) : R;
        voffA[i] = (unsigned)(R * K + C) * 2u; voffB[i] = (unsigned)(Rb * K + C) * 2u; }
    const size_t kstep = (size_t)(BK * 2);
    const size_t hstep = (size_t)HALF * K * 2;
    const size_t tstep = 2 * hstep;
    const unsigned ldsw = (unsigned)wid * 1024u;
    const int aoff = lds_byte(wr * 64 + fr, fq * 8), boff = lds_byte(wc * 32 + fr, fq * 8);
#define PG8_SA(b, h) (((b) * 2 + (h)) * HTB)
#define PG8_SB(b, h) ((4 + (b) * 2 + (h)) * HTB)
#define PG8_STAGE(bufoff, gbase, voff) do { _Pragma("unroll") for (int _i = 0; _i < 2; ++_i) \
        __builtin_amdgcn_global_load_lds((const unsigned*)((const char*)(gbase) + (voff)[_i]), (PG8_LAS unsigned*)(lds + (bufoff) + ldsw + _i * 8192), 16, 0, 0); } while (0)
#define PG8_LDA(dst, b, h) do { _Pragma("unroll") for (int m = 0; m < 4; ++m) _Pragma("unroll") for (int k = 0; k < 2; ++k) dst[m][k] = *(const PG8_LAS bf16x8*)(lds + PG8_SA(b, h) + aoff + m * 2048 + k * 1024); } while (0)
#define PG8_LDB(dst, b, h) do { _Pragma("unroll") for (int n = 0; n < 2; ++n) _Pragma("unroll") for (int k = 0; k < 2; ++k) dst[n][k] = *(const PG8_LAS bf16x8*)(lds + PG8_SB(b, h) + boff + n * 2048 + k * 1024); } while (0)
#define PG8_MMA(ai, bj, At, Bt) do { __builtin_amdgcn_s_setprio(1); _Pragma("unroll") for (int m = 0; m < 4; ++m) _Pragma("unroll") for (int n = 0; n < 2; ++n) _Pragma("unroll") for (int k = 0; k < 2; ++k) \
        acc[ai][bj][m][n] = __builtin_amdgcn_mfma_f32_16x16x32_bf16(Bt[n][k], At[m][k], acc[ai][bj][m][n], 0, 0, 0); __builtin_amdgcn_s_setprio(0); } while (0)
#define PG8_WAIT_V(n) asm volatile("s_waitcnt vmcnt(" #n ")" ::: "memory")
#define PG8_WAIT_L(n) asm volatile("s_waitcnt lgkmcnt(" #n ")" ::: "memory")
#define PG8_BAR __builtin_amdgcn_s_barrier()
#define PG8_SCHED __builtin_amdgcn_sched_barrier(0)
    Unit cur, nxt; int ui = 0;
    if (!S.next(0, cur)) return;
    f32x4 acc[2][2][4][2];
#pragma unroll
    for (int a = 0; a < 2; ++a)
#pragma unroll
        for (int b = 0; b < 2; ++b)
#pragma unroll
            for (int m = 0; m < 4; ++m)
#pragma unroll
                for (int n = 0; n < 2; ++n) acc[a][b][m][n] = (f32x4){0.f, 0.f, 0.f, 0.f};
    bf16x8 At[4][2], B0[2][2], B1[2][2];
    const char* cA = (const char*)g.A + (size_t)cur.pm * tstep; const char* cB = (const char*)g.Bt + (size_t)cur.pn * tstep;
    S.a_ready(cur);
    if constexpr (SP2) {
        PG8_STAGE(PG8_SB(0, 0), cB, voffB); PG8_STAGE(PG8_SB(0, 1), cB + hstep, voffB); PG8_STAGE(PG8_SA(0, 0), cA, voffA); PG8_STAGE(PG8_SA(0, 1), cA + hstep, voffA);
        if (wr == 1) PG8_BAR;
        PG8_WAIT_V(2); PG8_BAR;
        PG8_STAGE(PG8_SB(1, 0), cB + kstep, voffB); PG8_STAGE(PG8_SA(1, 0), cA + kstep, voffA); PG8_STAGE(PG8_SB(1, 1), cB + hstep + kstep, voffB);
        PG8_WAIT_V(6); PG8_BAR;
    } else {
        PG8_STAGE(PG8_SB(0, 0), cB, voffB); PG8_STAGE(PG8_SA(0, 0), cA, voffA); PG8_STAGE(PG8_SB(0, 1), cB + hstep, voffB); PG8_STAGE(PG8_SA(0, 1), cA + hstep, voffA);
        if (wr == 1) PG8_BAR;
        PG8_WAIT_V(4); PG8_BAR;
        PG8_STAGE(PG8_SB(1, 0), cB + kstep, voffB); PG8_STAGE(PG8_SA(1, 0), cA + kstep, voffA); PG8_STAGE(PG8_SB(1, 1), cB + hstep + kstep, voffB);
        PG8_WAIT_V(6); PG8_BAR;
    }
    for (;;) {
        const bool has_next = S.next(ui + 1, nxt);
        const char* nA = has_next ? (const char*)g.A + (size_t)nxt.pm * tstep : cA; const char* nB = has_next ? (const char*)g.Bt + (size_t)nxt.pn * tstep : cB;
        for (int t = 0; t < nt; t += 2) {
            const bool last = (t == nt - 2);
            const char* a1 = cA + (size_t)(t + 1) * kstep;
            const char* a2 = last ? nA : cA + (size_t)(t + 2) * kstep; const char* b2 = last ? nB : cB + (size_t)(t + 2) * kstep;
            const char* a3 = a2 + kstep; const char* b3 = b2 + kstep;
            if (last && has_next) S.a_ready(nxt);
            if constexpr (SP2) {
            PG8_LDB(B0, 0, 0); PG8_LDB(B1, 0, 1); PG8_SCHED; PG8_LDA(At, 0, 0); PG8_STAGE(PG8_SA(1, 1), a1 + hstep, voffA);
            PG8_WAIT_V(8); PG8_WAIT_L(0); PG8_BAR; PG8_MMA(0, 0, At, B0); PG8_MMA(0, 1, At, B1); PG8_BAR; PG8_SCHED;
            PG8_LDA(At, 0, 1); PG8_STAGE(PG8_SB(0, 0), b2, voffB); PG8_STAGE(PG8_SB(0, 1), b2 + hstep, voffB); PG8_STAGE(PG8_SA(0, 0), a2, voffA);
            PG8_WAIT_V(8); PG8_WAIT_L(0); PG8_BAR; PG8_MMA(1, 0, At, B0); PG8_MMA(1, 1, At, B1); PG8_BAR; PG8_SCHED;
            PG8_LDB(B0, 1, 0); PG8_LDB(B1, 1, 1); PG8_SCHED; PG8_LDA(At, 1, 0); PG8_STAGE(PG8_SA(0, 1), a2 + hstep, voffA);
            PG8_WAIT_V(8); PG8_WAIT_L(0); PG8_BAR; PG8_MMA(0, 0, At, B0); PG8_MMA(0, 1, At, B1); PG8_BAR; PG8_SCHED;
            PG8_LDA(At, 1, 1); PG8_STAGE(PG8_SB(1, 0), b3, voffB); PG8_STAGE(PG8_SB(1, 1), b3 + hstep, voffB); PG8_STAGE(PG8_SA(1, 0), a3, voffA);
            PG8_WAIT_V(8); PG8_WAIT_L(0); PG8_BAR; PG8_MMA(1, 0, At, B0); PG8_MMA(1, 1, At, B1); PG8_BAR; PG8_SCHED;
            } else {
            PG8_LDB(B0, 0, 0); PG8_SCHED; PG8_LDA(At, 0, 0); PG8_STAGE(PG8_SA(1, 1), a1 + hstep, voffA);
            PG8_WAIT_L(8); PG8_BAR; PG8_WAIT_L(0); PG8_MMA(0, 0, At, B0); PG8_BAR; PG8_SCHED;
            PG8_LDB(B1, 0, 1); PG8_STAGE(PG8_SB(0, 0), b2, voffB);
            PG8_BAR; PG8_WAIT_L(0); PG8_MMA(0, 1, At, B1); PG8_BAR;
            PG8_LDA(At, 0, 1); PG8_STAGE(PG8_SA(0, 0), a2, voffA);
            PG8_BAR; PG8_WAIT_L(0); PG8_MMA(1, 0, At, B0); PG8_BAR; PG8_SCHED;
            PG8_STAGE(PG8_SB(0, 1), b2 + hstep, voffB);
            PG8_WAIT_V(6); PG8_BAR; PG8_MMA(1, 1, At, B1); PG8_BAR;
            PG8_LDB(B0, 1, 0); PG8_SCHED; PG8_LDA(At, 1, 0); PG8_STAGE(PG8_SA(0, 1), a2 + hstep, voffA);
            PG8_WAIT_L(8); PG8_BAR; PG8_WAIT_L(0); PG8_MMA(0, 0, At, B0); PG8_BAR; PG8_SCHED;
            PG8_LDB(B1, 1, 1); PG8_STAGE(PG8_SB(1, 0), b3, voffB);
            PG8_BAR; PG8_WAIT_L(0); PG8_MMA(0, 1, At, B1); PG8_BAR;
            PG8_LDA(At, 1, 1); PG8_STAGE(PG8_SA(1, 0), a3, voffA);
            PG8_BAR; PG8_WAIT_L(0); PG8_MMA(1, 0, At, B0); PG8_BAR; PG8_SCHED;
            PG8_STAGE(PG8_SB(1, 1), b3 + hstep, voffB);
            PG8_WAIT_V(6); PG8_BAR; PG8_MMA(1, 1, At, B1); PG8_BAR;
            }
        }
        if constexpr (ALIGN_EPI) { if (wr == 0) PG8_BAR; }
        if constexpr (!Epi::AFTER_DRAIN) { E(acc, cur, wr, wc, fr, fq); S.done(cur); }
        if (!has_next) break;
#pragma unroll
        for (int a = 0; a < 2; ++a)
#pragma unroll
            for (int b = 0; b < 2; ++b)
#pragma unroll
                for (int m = 0; m < 4; ++m)
#pragma unroll
                    for (int n = 0; n < 2; ++n) acc[a][b][m][n] = (f32x4){0.f, 0.f, 0.f, 0.f};
        cur = nxt; cA = nA; cB = nB; ++ui;
        if constexpr (ALIGN_EPI) { if (wr == 1) PG8_BAR; }
    }
    PG8_WAIT_V(0);
    if constexpr (!ALIGN_EPI) { if (wr == 0) PG8_BAR; }
    PG8_BAR;
    if constexpr (Epi::AFTER_DRAIN) { E.fused(acc, cur, wr, wc, fr, fq, lds, wid, lane); S.done(cur); }
#undef PG8_SA
#undef PG8_SB
#undef PG8_STAGE
#undef PG8_LDA
#undef PG8_LDB
#undef PG8_MMA
#undef PG8_WAIT_V
#undef PG8_WAIT_L
#undef PG8_BAR
#undef PG8_SCHED
}
}
constexpr int NWAVES = 8, NTHR = 512;
constexpr int BATCH = 8, SEQ = 4096, DM = 1024, DEPTH = 4, M = BATCH * SEQ;
constexpr int DFF = 2816, NFF1 = 2 * DFF;
constexpr int GLA_H = 4, GLA_DK = 384, GLA_DV = 768, GLA_DKH = 96, GLA_DVH = 192, GLA_R = 16;
constexpr int FOX_H = 6, FOX_DH = 128, MAIN_W = 768, MEM_W = 256, MEM_H = 4, MEM_DH = 64, MEM_LEN = 256;
constexpr int A_IN_W = 2576, NA = 2816  , NB = 1024, NKV = 1536;
constexpr int PA_Q = 0, PA_K = 384, PA_V = 768, PA_R = 1536, PA_QM = 2304, PA_GL = 2560;
constexpr float EPS = 1e-6f;
constexpr int MEMROWS = BATCH * MEM_LEN;
constexpr int NMEMKV = DEPTH * 2 * MEM_W;

constexpr size_t MiB = 1u << 20;
constexpr size_t WS_CTL = 0, CTL_ZERO_BYTES = 32768;
constexpr size_t WS_W1 = 1 * MiB;
constexpr size_t WS_W2 = WS_W1 + 88 * MiB;
constexpr size_t WS_WA = WS_W2 + 44 * MiB;
constexpr size_t WS_WB = WS_WA + 11 * MiB;
constexpr size_t WS_WO = WS_WB + 4 * MiB;
constexpr size_t WS_WKV = WS_WO + 8 * MiB;
constexpr size_t WS_WM = WS_WKV + 3 * MiB;
constexpr size_t WS_HI = WS_WM + 4 * MiB;
constexpr size_t WS_LO = WS_HI + 64 * MiB;
constexpr size_t WS_MEMN = WS_LO + 64 * MiB;
constexpr size_t WS_MEMKV = WS_MEMN + 4 * MiB;
constexpr size_t WS_SMALL = WS_MEMKV + 8 * MiB;
constexpr size_t WS_KBIAS = WS_SMALL + 2 * MiB;
constexpr size_t WS_STATS = WS_LO + 32 * MiB;
constexpr int NSTATS = 13;
constexpr size_t WS_N2 = WS_SMALL + 5 * MiB;
constexpr size_t WS_KMAX = WS_SMALL + 1 * MiB + 768 * 1024;
constexpr size_t WS_R1 = WS_SMALL + 8 * MiB;
constexpr size_t WS_R2 = WS_R1 + 176 * MiB;
constexpr size_t WS_KV = WS_R2 + 64 * MiB;
constexpr size_t WS_END = WS_R2 + 176 * MiB;
static_assert(WS_END == 663 * MiB, "ws map");
constexpr int CW_BAR = 4096;

constexpr int RING_OFF = 0, RING_BYTES = 131072;
constexpr int LDSCTL_OFF = RING_BYTES, MISC_OFF = LDSCTL_OFF + 320;
constexpr int LDS_BYTES = 147456;
#define GAS __attribute__((address_space(1)))
#define LAS __attribute__((address_space(3)))
typedef unsigned short bf16;
typedef unsigned v4u __attribute__((ext_vector_type(4)));
typedef float f32x4 __attribute__((ext_vector_type(4)));
typedef short bf16x8 __attribute__((ext_vector_type(8)));
typedef GAS unsigned gu32;
typedef GAS unsigned long long gu64;
#define RLX_AGENT __ATOMIC_RELAXED, __HIP_MEMORY_SCOPE_AGENT
#define LDS_WAIT() asm volatile("s_waitcnt lgkmcnt(0)" ::: "memory")
#define VM_WAIT() asm volatile("s_waitcnt vmcnt(0)" ::: "memory")
__device__ __forceinline__ unsigned long long rt() { return __builtin_amdgcn_s_memrealtime(); }
__device__ __forceinline__ unsigned f2bf(float f) { unsigned u = __builtin_bit_cast(unsigned, f); return (u + 0x7fffu + ((u >> 16) & 1u)) >> 16; }
__device__ __forceinline__ unsigned pk2(float lo, float hi) { return f2bf(lo) | (f2bf(hi) << 16); }

#define XB_TMO      128
#define XB_XCNT(j)  (256  + 64 * (j))
#define XB_XSUB(j)  (1280 + 64 * (j))
#define XB_XGEN(j)  (2304 + 64 * (j))
#define XB_TOP      3328
#define XB_TOPGEN   3392
#define XCD_BAR_WORDS 3456
#define XB_SPIN_CAP (1u << 22)

__device__ __forceinline__ unsigned xb_ld(unsigned* p)              { return __hip_atomic_load(p, __ATOMIC_RELAXED, __HIP_MEMORY_SCOPE_AGENT); }
__device__ __forceinline__ unsigned xb_add(unsigned* p, unsigned v) { return __hip_atomic_fetch_add(p, v, __ATOMIC_RELAXED, __HIP_MEMORY_SCOPE_AGENT); }
__device__ __forceinline__ unsigned xb_xcc_id() { return (unsigned)__builtin_amdgcn_s_getreg((3 << 11) | 20) & 0xFu; }
#define XB_SPIN(cond, bar) do { unsigned _sp = 0; while (cond) { __builtin_amdgcn_s_sleep(1); \
    if ((++_sp & 255u) == 0u) { if (xb_ld(&(bar)[XB_TMO])) break; if (_sp > XB_SPIN_CAP) { atomicAdd(&(bar)[XB_TMO], 1u); break; } } } } while (0)

struct XcdBarrier {
    unsigned* bar; unsigned x;
    volatile LAS unsigned* st;
};

__device__ __forceinline__ XcdBarrier xcd_barrier_post(unsigned* bar, volatile LAS unsigned* st, const int tid_in) {
    XcdBarrier b; b.bar = bar; b.x = xb_xcc_id(); b.st = st;
    if (tid_in == 0) (void)xb_add(&bar[XB_XCNT(b.x)], 1u);
    return b;
}
__device__ __forceinline__ void xcd_barrier_complete(unsigned* bar, unsigned x, unsigned& nloc, unsigned& nx) {
    const unsigned G = gridDim.x * gridDim.y * gridDim.z;
    unsigned sum, cnt, mine, sp = 0u;
    for (;;) {
        sum = 0u; cnt = 0u; mine = 0u;
#pragma unroll
        for (unsigned j = 0; j < 16; ++j) { const unsigned c = xb_ld(&bar[XB_XCNT(j)]); sum += c; cnt += (c > 0u) ? 1u : 0u; mine = (j == x) ? c : mine; }
        if (sum == G) break;
        __builtin_amdgcn_s_sleep(1);
        if ((++sp & 255u) == 0u) { if (xb_ld(&bar[XB_TMO])) break; if (sp > XB_SPIN_CAP) { atomicAdd(&bar[XB_TMO], 1u); break; } }
    }
    nloc = mine > 0u ? mine : 1u; nx = cnt > 0u ? cnt : 1u;
}

__device__ __forceinline__ void xcd_barrier(const XcdBarrier& b, const int tid_in) {
    asm volatile("s_waitcnt vmcnt(0)" ::: "memory");
    __syncthreads();
    if (tid_in == 0) {
        unsigned* bar = b.bar;
        __builtin_amdgcn_s_waitcnt(0);
        unsigned nloc = b.st[0], nx = b.st[1];
        if (nloc == 0u) { xcd_barrier_complete(bar, b.x, nloc, nx); b.st[0] = nloc; b.st[1] = nx; }
        const unsigned old = xb_add(&bar[XB_XSUB(b.x)], 1u);
        const unsigned gen = old / nloc;
        if (old + 1u == (gen + 1u) * nloc) {
            __builtin_amdgcn_fence(__ATOMIC_RELEASE, "agent");
            asm volatile("s_waitcnt vmcnt(0)" ::: "memory");
            const unsigned og = xb_add(&bar[XB_TOP], 1u);
            const unsigned tg = og / nx;
            if (og + 1u == (tg + 1u) * nx) xb_add(&bar[XB_TOPGEN], 1u);
            else XB_SPIN(xb_ld(&bar[XB_TOPGEN]) == tg, bar);
            __builtin_amdgcn_fence(__ATOMIC_ACQUIRE, "agent");
            xb_add(&bar[XB_XGEN(b.x)], 1u);
            asm volatile("s_waitcnt vmcnt(0)" ::: "memory");
        } else {
            XB_SPIN(xb_ld(&bar[XB_XGEN(b.x)]) == gen, bar);
            __builtin_amdgcn_fence(__ATOMIC_ACQUIRE, "agent");
            asm volatile("s_waitcnt vmcnt(0)" ::: "memory");
        }
    }
    __syncthreads();
}

#define XB_GMASK(g) (3456 + 16 * (g))
#define XB_LSUB(g)  (3584 + 32 * (g))
#define XB_LGEN(g)  (3840 + 32 * (g))
__device__ __forceinline__ void xcd_local_post(unsigned* bar, const int tid_in, const int bx) {
    if (tid_in == 0) (void)__hip_atomic_fetch_or(&bar[XB_GMASK(bx & 7)], 1u << xb_xcc_id(), __ATOMIC_RELAXED, __HIP_MEMORY_SCOPE_AGENT);
}
__device__ __forceinline__ void xcd_seam(const XcdBarrier& b, const int tid_in, const int bx, const int G) {
    asm volatile("s_waitcnt vmcnt(0)" ::: "memory");
    if (tid_in == 0 && b.st[2] == 0u) { unsigned ok = (G % 8 == 0) ? 1u : 0u;
#pragma unroll
        for (int g = 0; g < 8; ++g) { const unsigned m = xb_ld(&b.bar[XB_GMASK(g)]); ok = (m != 0u && (m & (m - 1u)) == 0u) ? ok : 0u; }
        b.st[2] = ok ? 1u : 2u; }
    __syncthreads();
    const unsigned mode = b.st[2];
    if (mode != 1u) { xcd_barrier(b, tid_in); return; }
    if (tid_in == 0) {
        unsigned* bar = b.bar; const unsigned g = (unsigned)bx & 7u, n = (unsigned)G / 8u;
        __builtin_amdgcn_s_waitcnt(0);
        const unsigned old = xb_add(&bar[XB_LSUB(g)], 1u);
        const unsigned gen = old / n;
        if (old + 1u == (gen + 1u) * n) xb_add(&bar[XB_LGEN(g)], 1u);
        else XB_SPIN(xb_ld(&bar[XB_LGEN(g)]) == gen, bar);
        __builtin_amdgcn_fence(__ATOMIC_ACQUIRE, "agent");
        asm volatile("s_waitcnt vmcnt(0)" ::: "memory");
    }
    __syncthreads();
}
__device__ __forceinline__ float wave_sum(float v) {
#pragma unroll
    for (int o = 1; o < 64; o <<= 1) v += __shfl_xor(v, o);
    return v;
}
__device__ __forceinline__ float bf2f(bf16 b) { return __builtin_bit_cast(float, (unsigned)b << 16); }
__device__ __forceinline__ float log_sigmoid_f(float z) { return fminf(z, 0.f) - log1pf(expf(-fabsf(z))); }

struct MapPlain { __device__ __forceinline__ void operator()(int r, int& sc, float& cs) const { sc = r; cs = 1.f; } };
struct MapResid { __device__ __forceinline__ void operator()(int r, int& sc, float& cs) const { const int t = r & 255, bj = t >> 7, wc = (t >> 5) & 3, fq = (t >> 3) & 3, lo3 = t & 7; sc = (r & ~255) + 64 * wc + 16 * fq + 8 * bj + lo3; cs = 1.f; } };
struct MapSwi   { __device__ __forceinline__ void operator()(int r, int& sc, float& cs) const { const int pn = r >> 8, x = r & 255; sc = x < 128 ? 128 * pn + x : DFF + 128 * pn + (x - 128); cs = 1.f; } };
struct MapInA   { __device__ __forceinline__ void operator()(int r, int& sc, float& cs) const {
    if (r < PA_QM) { sc = r; cs = r < GLA_DK ? 0.10206207261596575f   : 1.f; }
    else if (r < PA_GL) { sc = r + GLA_R; cs = 0.125f; }
    else if (r < PA_GL + GLA_R) { sc = r - MEM_W; cs = 1.f; }
    else { sc = -1; cs = 0.f; } } };
struct MapInB   { __device__ __forceinline__ void operator()(int r, int& sc, float& cs) const { sc = r; cs = r < MAIN_W ? 1.f : 0.125f; } };
template <class Map>
__device__ __forceinline__ void transpose_item(const float* W, int K, int N, int NR, bf16* WT, LAS float* scr, int item, int lane, const float* kscale, Map map) {
    const int nblk = NR / 64, kb = item / nblk, nb = item - kb * nblk, k0 = 64 * kb, n0 = 64 * nb;
    const int rp = lane >> 4, n4 = lane & 15;
    int sc; float cs; map(n0 + 4 * n4, sc, cs);
    LAS unsigned* T = (LAS unsigned*)scr;
    f32x4 a[8], b[8];
    const float ksv = kscale ? kscale[k0 + lane] : 1.f;
#pragma unroll
    for (int j = 0; j < 8; ++j) { const int kp = 4 * j + rp;
        if (sc >= 0) { a[j] = __builtin_nontemporal_load((const GAS f32x4*)(W + (size_t)(k0 + 2 * kp) * N + sc)); b[j] = __builtin_nontemporal_load((const GAS f32x4*)(W + (size_t)(k0 + 2 * kp + 1) * N + sc)); }
        else { a[j] = (f32x4){0.f, 0.f, 0.f, 0.f}; b[j] = a[j]; } }
    scr[2112 + lane] = ksv;
#pragma unroll
    for (int j = 0; j < 8; ++j) { const int kp = 4 * j + rp; const pg8::f32x2 k2 = *(const LAS pg8::f32x2*)(scr + 2112 + 2 * kp); const float k0_ = k2[0], k1_ = k2[1], sa = cs * k0_, sb = cs * k1_;
        const f32x4 x = a[j] * sa, y = b[j] * sb;
        typedef unsigned u32x2 __attribute__((ext_vector_type(2)));
        LAS u32x2* d = (LAS u32x2*)(T + kp * 66 + 4 * n4);
        d[0] = (u32x2){pg8::cvt_pk_bf16(x.x, y.x), pg8::cvt_pk_bf16(x.y, y.y)}; d[1] = (u32x2){pg8::cvt_pk_bf16(x.z, y.z), pg8::cvt_pk_bf16(x.w, y.w)}; }
    LDS_WAIT(); asm volatile("" ::: "memory");
#pragma unroll
    for (int q = 0; q < 8; ++q) { const int id = q * 64 + lane, n = id >> 3, c = id & 7; const LAS unsigned* s = T + (4 * c) * 66 + n;
        v4u o; o.x = s[0]; o.y = s[66]; o.z = s[132]; o.w = s[198];
        *(GAS v4u*)(WT + (size_t)(n0 + n) * K + k0 + 8 * c) = o; }
    LDS_WAIT(); asm volatile("" ::: "memory");
}

#define T24_DEC(hwd, lwd, k) __builtin_bit_cast(float, __builtin_amdgcn_perm((hwd), (lwd), (((5u + 2u * ((k) & 1u)) << 24) | ((4u + 2u * ((k) & 1u)) << 16) | (((k) & 3u) << 8) | 0x0cu)))
struct RowArgs { const float* src; const bf16* shi; const unsigned char* slo; const float* gain; bf16* hi; unsigned char* lo; unsigned long long* ss; bf16* xn; float* outf; const float* wf; const float* bfg; float* logf; int rows; };
__device__ __forceinline__ void row_phase(const RowArgs& a, int gw, int NGW, int lane) {
    f32x4 nv[4]; unsigned long long nh[4];
#pragma unroll
    for (int j = 0; j < 4; ++j) { nv[j] = (f32x4){0.f, 0.f, 0.f, 0.f}; nh[j] = 0ull; }
#define ROW_LOAD(m_) do { if (a.src) { const GAS f32x4* xr = (const GAS f32x4*)(a.src + (size_t)(m_) * DM) + lane; _Pragma("unroll") for (int j = 0; j < 4; ++j) nv[j] = __builtin_nontemporal_load(xr + 64 * j); }    \
        else { const GAS unsigned long long* hr = (const GAS unsigned long long*)(a.shi + (size_t)(m_) * DM) + lane; _Pragma("unroll") for (int j = 0; j < 4; ++j) nh[j] = hr[64 * j]; } } while (0)
    f32x4 gn[4];
#pragma unroll
    for (int j = 0; j < 4; ++j) gn[j] = (a.outf || a.logf) ? ((const GAS f32x4*)a.gain)[lane + 64 * j] : (f32x4){1.f, 1.f, 1.f, 1.f};
    if (gw < a.rows) ROW_LOAD(gw);
    for (int m = gw; m < a.rows; m += NGW) {
        f32x4 v[4]; float s = 0.f;
        if (a.src) {
#pragma unroll
            for (int j = 0; j < 4; ++j) v[j] = nv[j]; }
        else {
#pragma unroll
            for (int j = 0; j < 4; ++j) { const unsigned long long hw = nh[j]; const unsigned h0 = (unsigned)hw, h1 = (unsigned)(hw >> 32);
                v[j].x = __uint_as_float(h0 << 16); v[j].y = __uint_as_float(h0 & 0xffff0000u); v[j].z = __uint_as_float(h1 << 16); v[j].w = __uint_as_float(h1 & 0xffff0000u); } }
        if (m + NGW < a.rows) ROW_LOAD(m + NGW);
#pragma unroll
        for (int j = 0; j < 4; ++j) s += (v[j].x * v[j].x + v[j].y * v[j].y) + (v[j].z * v[j].z + v[j].w * v[j].w);
        s = wave_sum(s);
        if (a.hi) { GAS unsigned long long* ho = (GAS unsigned long long*)(a.hi + (size_t)m * DM) + lane; GAS unsigned* lo = (GAS unsigned*)(a.lo + (size_t)m * DM) + lane; float st = 0.f;
#pragma unroll
            for (int j = 0; j < 4; ++j) { const float fx = v[j].x, fy = v[j].y, fz = v[j].z, fw = v[j].w;
#if STREAM16
                (void)lo; const unsigned p0 = pg8::cvt_pk_bf16(fx, fy), p1 = pg8::cvt_pk_bf16(fz, fw);
                ho[64 * j] = (unsigned long long)p0 | ((unsigned long long)p1 << 32);
                const float t0 = __uint_as_float(p0 << 16), t1 = __uint_as_float(p0 & 0xffff0000u), t2 = __uint_as_float(p1 << 16), t3 = __uint_as_float(p1 & 0xffff0000u);
                st += (t0 * t0 + t1 * t1) + (t2 * t2 + t3 * t3); }
#else
                const unsigned w0 = __float_as_uint(fx) + 0x80u, w1 = __float_as_uint(fy) + 0x80u, w2 = __float_as_uint(fz) + 0x80u, w3 = __float_as_uint(fw) + 0x80u;
                ho[64 * j] = (unsigned long long)__builtin_amdgcn_perm(w1, w0, 0x07060302u) | ((unsigned long long)__builtin_amdgcn_perm(w3, w2, 0x07060302u) << 32);
                lo[64 * j] = __builtin_amdgcn_perm(w1, w0, 0x0c0c0501u) | (__builtin_amdgcn_perm(w3, w2, 0x0c0c0501u) << 16);
                const float t0 = __builtin_bit_cast(float, w0 & 0xffff0000u), t1 = __builtin_bit_cast(float, w1 & 0xffff0000u), t2 = __builtin_bit_cast(float, w2 & 0xffff0000u), t3 = __builtin_bit_cast(float, w3 & 0xffff0000u);
                st += (t0 * t0 + t1 * t1) + (t2 * t2 + t3 * t3); }
#endif
            st = wave_sum(st); if (lane == 0) a.ss[m] = (unsigned long long)(st * 4294967296.0f); }
        const float rstd = 1.0f / sqrtf(s * (1.f / DM) + EPS);
        if (a.xn) { GAS unsigned long long* o8 = (GAS unsigned long long*)(a.xn + (size_t)m * DM) + lane;
#pragma unroll
            for (int j = 0; j < 4; ++j) o8[64 * j] = (unsigned long long)pk2(v[j].x * rstd, v[j].y * rstd) | ((unsigned long long)pk2(v[j].z * rstd, v[j].w * rstd) << 32); }
        if (a.outf || a.logf) {
#pragma unroll
            for (int j = 0; j < 4; ++j) v[j] = v[j] * rstd * gn[j]; }
        if (a.outf) { GAS f32x4* o = (GAS f32x4*)(a.outf + (size_t)m * DM) + lane;
#pragma unroll
            for (int j = 0; j < 4; ++j) o[64 * j] = v[j]; }
        if (a.logf) {
            float z[FOX_H];
#pragma unroll
            for (int h = 0; h < FOX_H; ++h) z[h] = 0.f;
#pragma unroll
            for (int j = 0; j < 4; ++j) { const float* w = a.wf + (size_t)(4 * lane + 256 * j) * FOX_H;
#pragma unroll
                for (int e = 0; e < 4; ++e)
#pragma unroll
                    for (int h = 0; h < FOX_H; ++h) z[h] += v[j][e] * w[e * FOX_H + h]; }
#pragma unroll
            for (int h = 0; h < FOX_H; ++h) { const float t = wave_sum(z[h]) + a.bfg[h]; if (lane == 0) a.logf[(size_t)m * FOX_H + h] = log_sigmoid_f(t); }
        }
    }
}

#undef ROW_LOAD
__device__ __forceinline__ void fgate_phase(const bf16* shi, const unsigned char* slo, const float* gain, const float* wf, const float* bfg, float* logf, int gw, int NGW, int lane) {
    float w[16][FOX_H];
#pragma unroll
    for (int j = 0; j < 4; ++j)
#pragma unroll
        for (int e = 0; e < 4; ++e) { const int c = 4 * lane + 256 * j + e; const float g = gain[c];
#pragma unroll
            for (int h = 0; h < FOX_H; ++h) w[4 * j + e][h] = g * wf[(size_t)c * FOX_H + h]; }
    for (int grp = gw; grp < M / 8; grp += NGW) {
        float v[64];
#pragma unroll
        for (int i = 56; i < 64; ++i) v[i] = 0.f;
#pragma unroll
        for (int r = 0; r < 8; ++r) { const size_t m = (size_t)grp * 8 + r;
            const GAS unsigned long long* hr = (const GAS unsigned long long*)(shi + m * DM) + lane; const GAS unsigned* lr = (const GAS unsigned*)(slo + m * DM) + lane;
            float z[FOX_H], sq = 0.f;
#pragma unroll
            for (int h = 0; h < FOX_H; ++h) z[h] = 0.f;
#pragma unroll
            for (int j = 0; j < 4; ++j) { const unsigned long long hw = hr[64 * j]; const unsigned h0 = (unsigned)hw, h1 = (unsigned)(hw >> 32);
#if STREAM16
                (void)lr; const float x0 = __uint_as_float(h0 << 16), x1 = __uint_as_float(h0 & 0xffff0000u), x2 = __uint_as_float(h1 << 16), x3 = __uint_as_float(h1 & 0xffff0000u);
#else
                const unsigned lw = lr[64 * j]; const float x0 = T24_DEC(h0, lw, 0u), x1 = T24_DEC(h0, lw, 1u), x2 = T24_DEC(h1, lw, 2u), x3 = T24_DEC(h1, lw, 3u);
#endif
                sq += (x0 * x0 + x1 * x1) + (x2 * x2 + x3 * x3);
#pragma unroll
                for (int h = 0; h < FOX_H; ++h) z[h] += (x0 * w[4 * j][h] + x1 * w[4 * j + 1][h]) + (x2 * w[4 * j + 2][h] + x3 * w[4 * j + 3][h]); }
#pragma unroll
            for (int h = 0; h < FOX_H; ++h) v[r * FOX_H + h] = z[h];
            v[48 + r] = sq; }
#define FG_TRED(m_, n_) do { const bool up = (lane & (m_)) != 0; _Pragma("unroll") for (int r = 0; r < (n_); ++r) { const float send = up ? v[r] : v[r + (n_)], keep = up ? v[r + (n_)] : v[r]; v[r] = keep + __shfl_xor(send, (m_)); } } while (0)
        FG_TRED(32, 32); FG_TRED(16, 16); FG_TRED(8, 8); FG_TRED(4, 4); FG_TRED(2, 2); FG_TRED(1, 1);
#undef FG_TRED
        const int r = lane / FOX_H, h = lane - r * FOX_H;
        const float sq = __shfl(v[0], 48 + (r & 7));
        if (lane < 48) { const size_t m = (size_t)grp * 8 + r; const float rstd = 1.0f / sqrtf(sq * (1.f / DM) + EPS);
            logf[m * FOX_H + h] = log_sigmoid_f(v[0] * rstd + bfg[h]); }
    }
}

__device__ __forceinline__ void dcum_phase(const float* logf, float* dcum, float* kbias, const float* kn2, float* kmax, int gw, int NGW, int lane) {
    for (int q = gw; q < BATCH * FOX_H; q += NGW) {
        const int b = q / FOX_H, h = q % FOX_H;
        const float* src = logf + ((size_t)b * SEQ + lane * 64) * FOX_H + h;
        float s = 0.f;
        for (int i = 0; i < 64; ++i) s += src[(size_t)i * FOX_H];
        float inc = s;
#pragma unroll
        for (int o = 1; o < 64; o <<= 1) { const float t = __shfl_up(inc, o); if (lane >= o) inc += t; }
        float run = inc - s;
        float* dst = dcum + (size_t)q * SEQ + lane * 64;
        float* dkb = kbias + (size_t)q * SEQ + lane * 64;
        for (int i = 0; i < 64; ++i) { run += src[(size_t)i * FOX_H]; dst[i] = run; dkb[i] = run * -11.313708498984761f; }
        { const float* kn = kn2 + (size_t)h * M + (size_t)b * SEQ; float mx = 0.f;
#pragma unroll 16
          for (int i = lane; i < SEQ; i += 64) mx = fmaxf(mx, kn[i]);
#pragma unroll
          for (int o = 1; o < 64; o <<= 1) mx = fmaxf(mx, __shfl_xor(mx, o));
          if (lane == 0) kmax[q] = mx; }
    }
}
namespace fox {
constexpr int D = 128, QP = 1024, KVP = 1536, OP = 1024;
constexpr bool WSKIP = false;
constexpr float THR = 8.f;
constexpr float SCALE = 0.08838834764831845f;
constexpr int NW = 8, QBLK = 32, KVBLK = 64, QB = NW * QBLK;
constexpr int SHM_V = KVBLK * D * 2, SHM_K = KVBLK * D * 2;
constexpr int LDS_KB = 2 * SHM_V + 2 * SHM_K + NW * 64 * 4;
constexpr int LDS_BYTES = LDS_KB + 2 * 64 * 4;


using bf16 = unsigned short;
typedef short bf16x8 __attribute__((ext_vector_type(8)));
typedef short s16x4 __attribute__((ext_vector_type(4)));
typedef float f32x16 __attribute__((ext_vector_type(16)));
typedef float f32x4 __attribute__((ext_vector_type(4)));
typedef unsigned u32x4 __attribute__((ext_vector_type(4)));
template <class A, class Bt> struct same_t { static constexpr bool v = false; };
template <class A> struct same_t<A, A> { static constexpr bool v = true; };

#define KSWZ(row, colB) ((row) * 256 + ((colB) ^ (((row) & 7) << 4)))
#define SBAR() __builtin_amdgcn_sched_barrier(0)
__device__ __forceinline__ int v_st(int k, int c) { const int kk = (k & ~0xC) | ((k & 4) << 1) | ((k & 8) >> 1); return ((kk >> 3) * 4 + (c >> 5)) * 512 + ((kk & 7) * 32 + (c & 31)) * 2; }
__device__ __forceinline__ int v_rd_base(int lane) { return ((lane & 3) << 3) | (((lane >> 2) & 3) << 6) | (((lane >> 4) & 1) << 5) | (((lane >> 5) & 1) << 8); }
constexpr int v_rd_off(int d0, int ks, int half) { return d0 * 512 + ks * 4096 + half * 2048; }
__device__ __forceinline__ int crow(int r, int hi) { return (r & 3) + 8 * (r >> 2) + 4 * hi; }
__device__ __forceinline__ unsigned cvtpk(float lo, float hi) {
    unsigned r; asm volatile("v_cvt_pk_bf16_f32 %0, %1, %2" : "=v"(r) : "v"(lo), "v"(hi)); return r;
}
__device__ __forceinline__ bf16x8 pack8(f32x4 a, f32x4 b) {
    u32x4 w = {cvtpk(a[0], a[1]), cvtpk(a[2], a[3]), cvtpk(b[0], b[1]), cvtpk(b[2], b[3])};
    return *reinterpret_cast<bf16x8*>(&w);
}
template <class T> __device__ __forceinline__ bf16x8 load8(const T* p) {
    if constexpr (same_t<T, float>::v) { return pack8(*(const f32x4*)p, *(const f32x4*)(p + 4)); }
    else { return *reinterpret_cast<const bf16x8*>(p); }
}
__device__ __forceinline__ void mask_tile(f32x16& p0, f32x16& p1, int dq, unsigned W) {
    const float NEG = -__builtin_inff();
#pragma unroll
    for (int r = 0; r < 16; ++r) {
        const int c = (r & 3) + 8 * (r >> 2);
        if ((unsigned)(dq - c) >= W) p0[r] = NEG;
        if ((unsigned)(dq - c - 32) >= W) p1[r] = NEG;
    }
}
__device__ __forceinline__ void partialSM(f32x16& p0, f32x16& p1, float& m_reg, float& mn, float& alpha) {
    float pmax = p0[0]; for (int r = 1; r < 16; ++r) pmax = fmaxf(pmax, p0[r]); for (int r = 0; r < 16; ++r) pmax = fmaxf(pmax, p1[r]);
    { auto rr = __builtin_amdgcn_permlane32_swap(__float_as_uint(pmax), __float_as_uint(pmax), false, false);
      pmax = fmaxf(__uint_as_float(rr[0]), __uint_as_float(rr[1])); }
    constexpr float C2 = 1.4426950408889634f * SCALE;
    if (__builtin_expect(__all((pmax - m_reg) * SCALE <= THR), 1)) { mn = m_reg; alpha = 1.f; }
    else { mn = fmaxf(m_reg, pmax); alpha = __builtin_amdgcn_exp2f((m_reg - mn) * C2); m_reg = mn; }
    const float mnL = -mn * C2;
    for (int r = 0; r < 16; ++r) p0[r] = fmaf(p0[r], C2, mnL); for (int r = 0; r < 16; ++r) p1[r] = fmaf(p1[r], C2, mnL);
    for (int r = 0; r < 16; ++r) p0[r] = __builtin_amdgcn_exp2f(p0[r]);
}
__device__ __forceinline__ void finishSM(f32x16& p0, f32x16& p1, float alpha, float& l_reg, bf16x8& pa0, bf16x8& pa1, bf16x8& pa2, bf16x8& pa3) {
    for (int r = 0; r < 16; ++r) p1[r] = __builtin_amdgcn_exp2f(p1[r]);
    float ps = 0; for (int r = 0; r < 16; ++r) ps += p0[r]; for (int r = 0; r < 16; ++r) ps += p1[r];
    { auto rr = __builtin_amdgcn_permlane32_swap(__float_as_uint(ps), __float_as_uint(ps), false, false);
      ps = __uint_as_float(rr[0]) + __uint_as_float(rr[1]); }
    l_reg = l_reg * alpha + ps;
#define PK4(P, B_, OUT) do { unsigned a0 = cvtpk(P[B_+0], P[B_+1]), a1 = cvtpk(P[B_+2], P[B_+3]);                          \
        unsigned b0 = cvtpk(P[B_+4], P[B_+5]), b1 = cvtpk(P[B_+6], P[B_+7]);                                             \
        auto r0 = __builtin_amdgcn_permlane32_swap(a0, b0, false, false); auto r1 = __builtin_amdgcn_permlane32_swap(a1, b1, false, false); \
        u32x4 w = {r0[0], r1[0], r0[1], r1[1]}; OUT = *reinterpret_cast<bf16x8*>(&w); } while (0)
    PK4(p0, 0, pa0); PK4(p0, 8, pa1); PK4(p1, 0, pa2); PK4(p1, 8, pa3);
#undef PK4
}
template <int KB, bool SK>
__device__ __forceinline__ void qkt(f32x16& p0, f32x16& p1, const char* K_lds, const float* kbl, int r32, int hi, const bf16x8* qr, bool act) {
    if (SK && !act) { const float NEG = -__builtin_inff();
#pragma unroll
        for (int r = 0; r < 16; ++r) { p0[r] = NEG; p1[r] = NEG; } return; }
    {
        const float* kb_ = kbl + KB * 64 + 4 * hi;
#pragma unroll
        for (int g_ = 0; g_ < 4; ++g_) { const f32x4 a_ = *(const f32x4*)(kb_ + 8 * g_), b_ = *(const f32x4*)(kb_ + 32 + 8 * g_);
            p0[4 * g_] = a_[0]; p0[4 * g_ + 1] = a_[1]; p0[4 * g_ + 2] = a_[2]; p0[4 * g_ + 3] = a_[3]; p1[4 * g_] = b_[0]; p1[4 * g_ + 1] = b_[1]; p1[4 * g_ + 2] = b_[2]; p1[4 * g_ + 3] = b_[3]; } }
    const char* kb[4];
#pragma unroll
    for (int dd = 0; dd < 4; ++dd) kb[dd] = K_lds + KB * SHM_K + KSWZ(r32, (dd * 16 + hi * 8) * 2);
#pragma unroll
    for (int d0 = 0; d0 < 8; ++d0) { const char* a = kb[d0 & 3] + (d0 >> 2) * 128;
        bf16x8 b0 = *reinterpret_cast<const bf16x8*>(a);
        bf16x8 b1 = *reinterpret_cast<const bf16x8*>(a + 32 * 256);
        p0 = __builtin_amdgcn_mfma_f32_32x32x16_bf16(b0, qr[d0], p0, 0, 0, 0);
        p1 = __builtin_amdgcn_mfma_f32_32x32x16_bf16(b1, qr[d0], p1, 0, 0, 0); }
}
template <int VB, bool SK>
__device__ __forceinline__ void pv_tile(f32x16* o, int vb0, bf16x8 pa0, bf16x8 pa1, bf16x8 pa2, bf16x8 pa3, bool act) {
    if (SK && !act) return;
#define TRRD(dst, off) asm volatile("ds_read_b64_tr_b16 %0, %1 offset:%2" : "=&v"(dst) : "v"(vb0), "i"(off) : "memory")
#define PV_D0(d0) do { s16x4 l0, l1, l2, l3, h0, h1, h2, h3; constexpr int b_ = VB * SHM_V + v_rd_off(d0, 0, 0);     \
        TRRD(l0, b_); TRRD(h0, b_ + 2048); TRRD(l1, b_ + 4096); TRRD(h1, b_ + 6144); TRRD(l2, b_ + 8192); TRRD(h2, b_ + 10240); TRRD(l3, b_ + 12288); TRRD(h3, b_ + 14336); \
        asm volatile("s_waitcnt lgkmcnt(0)" ::: "memory"); SBAR();                 \
        o[d0] = __builtin_amdgcn_mfma_f32_32x32x16_bf16(pa0, (bf16x8){l0[0], l0[1], l0[2], l0[3], h0[0], h0[1], h0[2], h0[3]}, o[d0], 0, 0, 0);   \
        o[d0] = __builtin_amdgcn_mfma_f32_32x32x16_bf16(pa1, (bf16x8){l1[0], l1[1], l1[2], l1[3], h1[0], h1[1], h1[2], h1[3]}, o[d0], 0, 0, 0);   \
        o[d0] = __builtin_amdgcn_mfma_f32_32x32x16_bf16(pa2, (bf16x8){l2[0], l2[1], l2[2], l2[3], h2[0], h2[1], h2[2], h2[3]}, o[d0], 0, 0, 0);   \
        o[d0] = __builtin_amdgcn_mfma_f32_32x32x16_bf16(pa3, (bf16x8){l3[0], l3[1], l3[2], l3[3], h3[0], h3[1], h3[2], h3[3]}, o[d0], 0, 0, 0); } while (0)
    PV_D0(0); PV_D0(1); PV_D0(2); PV_D0(3);
#undef PV_D0
#undef TRRD
}

struct Tensors { const bf16* Qp; const bf16* KVp; bf16* Op; const float* KBp; };
template <class TIn, class TOut> struct BlockRef { int qo, kv, kb, P0; };
template <class TIn> struct Seam {
    bf16x8 qr[8];
    bf16x8 st_v0, st_v1, st_k0, st_k1; f32x4 sf0, sf1, sf2, sf3;
    float st_b;
    f32x4 tq[16];
};
__device__ __forceinline__ int swa_jlo(int P0, int W) { const int lowk = P0 - W + 1; return lowk > 0 ? lowk / KVBLK : 0; }
#define ROW(p, k0, rr) ((p) + (size_t)((k0) + (rr)) * KVP + sc)
#define VMW() asm volatile("s_waitcnt vmcnt(0)" ::: "memory")
#define VMWN(n) asm volatile("s_waitcnt vmcnt(%0)" :: "i"(n) : "memory")
#define SLOAD_H(Kp, Vp, KBp, k0, bb) do { S.st_v0 = load8<TIn>(ROW(Vp, k0, sr)); S.st_v1 = load8<TIn>(ROW(Vp, k0, 32 + sr));              \
                         S.st_k0 = load8<TIn>(ROW(Kp, k0, sr)); S.st_k1 = load8<TIn>(ROW(Kp, k0, 32 + sr));                              \
                         S.st_b = (KBp)[(k0) + lane]; (void)(bb); } while (0)
#define SWRITE_HK(bf) do { *(bf16x8*)(K_lds + (bf) * SHM_K + kws) = S.st_k0; *(bf16x8*)(K_lds + (bf) * SHM_K + kws + 32 * 256) = S.st_k1; kb_lds[(bf) * 64 + lane] = S.st_b; } while (0)
#define SWRITE_HV(bf) do { *(bf16x8*)(V_lds + (bf) * SHM_V + vst0) = S.st_v0; *(bf16x8*)(V_lds + (bf) * SHM_V + vst1) = S.st_v1; } while (0)
#define SWRITE_H(bf) do { SWRITE_HV(bf); SWRITE_HK(bf); } while (0)
#define SLOAD_F(p, k0) do { S.sf0 = *(const f32x4*)ROW(p, k0, sr); S.sf1 = *(const f32x4*)(ROW(p, k0, sr) + 4);                \
                            S.sf2 = *(const f32x4*)ROW(p, k0, 32 + sr); S.sf3 = *(const f32x4*)(ROW(p, k0, 32 + sr) + 4); } while (0)
#define SWRITE_KF(bf) do { *(bf16x8*)(K_lds + (bf) * SHM_K + kws) = pack8(S.sf0, S.sf1); *(bf16x8*)(K_lds + (bf) * SHM_K + kws + 32 * 256) = pack8(S.sf2, S.sf3); } while (0)
#define SWRITE_VF(bf) do { *(bf16x8*)(V_lds + (bf) * SHM_V + vst0) = pack8(S.sf0, S.sf1); *(bf16x8*)(V_lds + (bf) * SHM_V + vst1) = pack8(S.sf2, S.sf3); } while (0)
template <class TIn, class TOut>
__device__ __forceinline__ void causal_swa_prime(const Tensors& T, const BlockRef<TIn, TOut>& cur, int W, char* lds, Seam<TIn>& S, const int tid_in) {
    constexpr bool F32 = same_t<TIn, float>::v;
    int tid_o = tid_in; asm volatile("" : "+v"(tid_o)); const int tid = tid_o, wid = __builtin_amdgcn_readfirstlane(tid >> 6), lane = tid & 63, r32 = lane & 31, hi = lane >> 5;
    const int sr = tid >> 4, sc = (tid & 15) * 8, kws = KSWZ(sr, sc * 2); char* K_lds = lds + 2 * SHM_V; float* kb_lds = (float*)(lds + LDS_KB);
    const int kb0 = (cur.P0 & 255) * KVBLK; (void)W;
    for (int d0 = 0; d0 < 8; ++d0) S.qr[d0] = load8<TIn>((T.Qp + cur.qo) + (size_t)(wid * QBLK + r32) * QP + d0 * 16 + hi * 8);
    if constexpr (F32) { SLOAD_F((const float*)(T.KVp + cur.kv), kb0); VMW(); SWRITE_KF(0); SBAR(); SLOAD_F((const float*)(T.KVp + cur.kv + 768), kb0); }
    else { SLOAD_H((T.KVp + cur.kv), (T.KVp + cur.kv + 768), (T.KBp + cur.kb), kb0, 0); VMW(); SWRITE_HK(0); }
    __syncthreads();
}
template <class TIn, class TOut>
__device__ __forceinline__ void causal_swa_block(const Tensors& T, const BlockRef<TIn, TOut>& cur, const BlockRef<TIn, TOut>& nxt, int skv, int W, char* lds, Seam<TIn>& S, const int tid_in) {
    constexpr bool F32 = same_t<TIn, float>::v;
    int tid_o = tid_in; asm volatile("" : "+v"(tid_o)); const int tid = tid_o, wid = __builtin_amdgcn_readfirstlane(tid >> 6), lane = tid & 63, r32 = lane & 31, hi = lane >> 5;
    const int j_lo = cur.P0 & 255, P0c = cur.P0 & ~255;
    int j_hi = (P0c + QB - 1) / KVBLK + 1; if (j_hi > skv / KVBLK) j_hi = skv / KVBLK;
    const int NT = j_hi - j_lo;
    const int kbn = (nxt.P0 & 255) * KVBLK;
    const int qlo = P0c + wid * QBLK, qm = qlo + r32 - 4 * hi;
    char* V_lds = lds; char* K_lds = lds + 2 * SHM_V; float* kb_lds = (float*)(lds + LDS_KB);
    float* ws = (float*)(lds + 2 * SHM_V + 2 * SHM_K) + wid * 64; float* li_l = ws, * al_l = ws + 32;
    float m_reg = -1e30f, l_reg = 0; f32x16 o[4] = {};
    const int sr = tid >> 4, sc = (tid & 15) * 8, vst0 = v_st(sr, sc), vst1 = v_st(32 + sr, sc), kws = KSWZ(sr, sc * 2);
    const int vb0 = (int)(uintptr_t)V_lds + v_rd_base(lane);
    const TIn* Kh = (T.KVp + cur.kv); const TIn* Vh = (T.KVp + cur.kv + 768); const float* KBh = (T.KBp + cur.kb);
#define RESC(a) do { if (__any((a) < 1.f)) { if (hi == 0) al_l[r32] = (a); asm volatile("s_waitcnt lgkmcnt(0)" ::: "memory");              \
                     for (int d_ = 0; d_ < 4; ++d_) for (int r = 0; r < 16; ++r) o[d_][r] *= al_l[crow(r, hi)]; } } while (0)
#define KBASE(t) ((j_lo + (t)) * KVBLK)
#define ACT(t) (KBASE(t) <= qlo + QBLK - 1 && KBASE(t) + KVBLK - 1 >= qlo - W + 1)
#define MASKT(P0_, P1_, t) do { const int kb_ = KBASE(t); if ((!SK || ACT(t)) && (kb_ + KVBLK - 1 > qlo || kb_ <= qlo + QBLK - 1 - W)) mask_tile(P0_, P1_, qm - kb_, (unsigned)W); } while (0)
    constexpr int NQL = F32 ? 16 : 8;
    constexpr bool SK = WSKIP && !F32;
#define SEAM_K0() do { VMWN(NQL); if constexpr (F32) { SWRITE_KF(0); SBAR(); SLOAD_F((const float*)(T.KVp + nxt.kv + 768), kbn); } else { SWRITE_HK(0); } SBAR(); } while (0)
    f32x16 pA0, pA1, pB0, pB1; float mnA, mnB, alA, alB; bf16x8 pa0, pa1, pa2, pa3;
    if constexpr (F32) { VMW(); SWRITE_VF(0); SBAR(); } else { SWRITE_HV(0); SBAR(); }
    if (NT > 1) { if constexpr (F32) SLOAD_F((const float*)Kh, KBASE(1)); else SLOAD_H(Kh, Vh, KBh, KBASE(1), 1); }
    SBAR(); qkt<0, SK>(pA0, pA1, K_lds, kb_lds, r32, hi, S.qr, ACT(0));
    if constexpr (F32) { if (NT > 1) { VMW(); SWRITE_KF(1); SBAR(); SLOAD_F((const float*)Vh, KBASE(1)); } }
    MASKT(pA0, pA1, 0); partialSM(pA0, pA1, m_reg, mnA, alA);
    if (NT > 1) { VMW(); if constexpr (F32) { SWRITE_VF(1); SBAR(); if (NT > 2) SLOAD_F((const float*)Kh, KBASE(2)); } else SWRITE_H(1); }
    __syncthreads();
#define HALF_STEP(PX0, PX1, mnX, alX, PY0, PY1, alY, t, KB, VB, SB) do {                                                      \
        SBAR(); qkt<KB, SK>(PX0, PX1, K_lds, kb_lds, r32, hi, S.qr, ACT(t));                                             \
        finishSM(PY0, PY1, alY, l_reg, pa0, pa1, pa2, pa3); SBAR();                                                           \
        if ((t) + 1 < NT) { if constexpr (F32) { VMW(); SWRITE_KF(SB); SBAR(); SLOAD_F((const float*)Vh, KBASE((t) + 1)); }  \
                            else { SLOAD_H(Kh, Vh, KBh, KBASE((t) + 1), SB); } SBAR(); }                                               \
        pv_tile<VB, SK>(o, vb0, pa0, pa1, pa2, pa3, ACT((t) - 1)); MASKT(PX0, PX1, (t)); partialSM(PX0, PX1, m_reg, mnX, alX);                                        \
        __syncthreads();                                                                                                      \
        if ((t) + 1 < NT) { VMW(); if constexpr (F32) { SWRITE_VF(SB); SBAR(); if ((t) + 2 < NT) SLOAD_F((const float*)Kh, KBASE((t) + 2)); } \
                            else { SWRITE_H(SB); } }                                                                          \
        RESC(alX); __syncthreads(); } while (0)
    for (int t = 1; t + 1 < NT; t += 2) {
        HALF_STEP(pB0, pB1, mnB, alB, pA0, pA1, alA, t, 1, 0, 0);
        HALF_STEP(pA0, pA1, mnA, alA, pB0, pB1, alB, t + 1, 0, 1, 1);
    }
    const bool even = (NT & 1) == 0;
    if (even) { SBAR(); qkt<1, SK>(pB0, pB1, K_lds, kb_lds, r32, hi, S.qr, ACT(NT - 1)); SBAR(); }
#define QROW(e) ((T.Qp + nxt.qo) + (size_t)(wid * QBLK + r32) * QP + ((e) >> 1) * 16 + hi * 8 + ((e) & 1) * 4)
    if constexpr (F32) { SLOAD_F((const float*)(T.KVp + nxt.kv), kbn); SBAR();
#pragma unroll
        for (int e = 0; e < 8; ++e) S.tq[e] = *(const f32x4*)QROW(e); }
    else { SLOAD_H((T.KVp + nxt.kv), (T.KVp + nxt.kv + 768), (T.KBp + nxt.kb), kbn, 0); SBAR();
#pragma unroll
        for (int d0 = 0; d0 < 8; ++d0) S.qr[d0] = load8<TIn>((T.Qp + nxt.qo) + (size_t)(wid * QBLK + r32) * QP + d0 * 16 + hi * 8); }
    SBAR();
    finishSM(pA0, pA1, alA, l_reg, pa0, pa1, pa2, pa3); SBAR();
    if constexpr (F32) {
#pragma unroll
        for (int e = 8; e < 16; ++e) S.tq[e] = *(const f32x4*)QROW(e); SBAR(); }
#undef QROW
    pv_tile<0, SK>(o, vb0, pa0, pa1, pa2, pa3, ACT(even ? NT - 2 : NT - 1));
    if (even) { MASKT(pB0, pB1, NT - 1); partialSM(pB0, pB1, m_reg, mnB, alB); __syncthreads(); RESC(alB);
        finishSM(pB0, pB1, alB, l_reg, pa0, pa1, pa2, pa3); SBAR(); pv_tile<1, SK>(o, vb0, pa0, pa1, pa2, pa3, ACT(NT - 1)); }
    SBAR(); SEAM_K0();
    if (hi == 0) li_l[r32] = l_reg; asm volatile("s_waitcnt lgkmcnt(0)" ::: "memory");
    float rli[16];
#pragma unroll
    for (int r = 0; r < 16; ++r) rli[r] = __builtin_amdgcn_rcpf(li_l[crow(r, hi)]);
    TOut* Ow = (T.Op + cur.qo) + (size_t)(wid * QBLK) * OP;
#pragma unroll
    for (int r = 0; r < 16; ++r) { const int orow = crow(r, hi);
#pragma unroll
        for (int d0 = 0; d0 < 4; ++d0) { const float v = o[d0][r] * rli[r];
            if constexpr (same_t<TOut, float>::v) { Ow[(size_t)orow * OP + d0 * 32 + r32] = v; }
            else { const float vn = __uint_as_float(__builtin_amdgcn_update_dpp(0u, __float_as_uint(v), 0xB1  , 0xf, 0xf, false));
                   if ((r32 & 1) == 0) *(unsigned*)(Ow + (size_t)orow * OP + d0 * 32 + r32) = cvtpk(v, vn); } } }
    if constexpr (F32) {
#pragma unroll
        for (int d0 = 0; d0 < 8; ++d0) S.qr[d0] = pack8(S.tq[2 * d0], S.tq[2 * d0 + 1]); }
    __syncthreads();
#undef RESC
#undef KBASE
#undef ACT
#undef MASKT
#undef SEAM_K0
#undef HALF_STEP
}
#undef ROW
#undef VMW
#undef VMWN
#undef SLOAD_H
#undef SWRITE_HK
#undef SWRITE_HV
#undef SWRITE_H
#undef SLOAD_F
#undef SWRITE_KF
#undef SWRITE_VF

typedef BlockRef<bf16, bf16> Ref;
struct Plan { const float* qn2; const float* kmax; const float* kb; };
__device__ __forceinline__ int block_jlo(const Plan& P, int bh, int qb, int lane) {
    const int b = bh / 6, h = bh - 6 * b, P0 = qb * QB;
    const float* qn = P.qn2 + (size_t)h * 32768 + (size_t)b * 4096 + P0;
    float q2 = fmaxf(fmaxf(qn[lane], qn[lane + 64]), fmaxf(qn[lane + 128], qn[lane + 192]));
#pragma unroll
    for (int o = 1; o < 64; o <<= 1) q2 = fmaxf(q2, __shfl_xor(q2, o));
    const float bound = 2.04f * SCALE * sqrtf(q2 * P.kmax[bh]);
    const float* kb = P.kb + (size_t)bh * 4096;
    const float rel = SCALE * (kb[64 * lane + 63] - kb[P0]);
    const unsigned long long dead = __ballot(bound + rel < -106.0f);
    return __popcll(dead);
}
__device__ __forceinline__ Ref mkref(int w) {
    const int bh = w & 0xff, qb = (w >> 8) & 0xff, b = bh / 6, h = bh - 6 * b; Ref r;
    static_assert(QP == OP, "one offset serves q and o");
    r.qo = (b * 4096 + qb * QB) * QP + h * D; r.kv = b * 4096 * KVP + h * D; r.kb = bh * 4096; r.P0 = qb * QB + ((w >> 16) & 0xff); return r;
}
__device__ __forceinline__ void fox_phase(char* lds, const Tensors& T, const Plan& P, int vcu, int G, const int tid_in) {
    int* slot = (int*)(lds + LDS_BYTES);
    int nblk = 0;
    if (G == 256) {
        nblk = 3;
        if (tid_in < 192) { const int k = tid_in >> 6, lane = tid_in & 63, t = vcu & 15; unsigned wd = 0u; const unsigned tab[16] = {0x01090bu, 0x02061bu, 0x03080au, 0x04050fu, 0x13180du, 0x14161du, 0x00191fu, 0x24262bu, 0x10072du, 0x25150eu, 0x23280cu, 0x11291cu, 0x121a2cu, 0x202a1eu, 0x22172fu, 0x21272eu};
#pragma unroll
            for (int i = 0; i < 16; ++i) if (t == i) wd = tab[i];
            const unsigned e = (wd >> (8 * k)) & 0xffu; const int qb = e & 15, bh = 3 * (vcu >> 4) + (int)(e >> 4); const int jl = block_jlo(P, bh, qb, lane);
            if (lane == 0) slot[k] = bh | (qb << 8) | (jl << 16); }
    } else { for (int i = vcu; i < 768 && nblk < 16; i += G) { if (tid_in == 0) slot[nblk] = (i % 48) | ((15 - i / 48) << 8); ++nblk; } }
    __syncthreads();
    if (nblk == 0) return;
    Ref cur = mkref(__builtin_amdgcn_readfirstlane(slot[0]));
    Seam<bf16> S;
    causal_swa_prime<bf16, bf16>(T, cur, 4096, lds, S, tid_in);
    for (int k = 0; k < nblk; ++k) {
        const Ref nxt = k + 1 < nblk ? mkref(__builtin_amdgcn_readfirstlane(slot[k + 1])) : cur;
        causal_swa_block<bf16, bf16>(T, cur, nxt, 4096, 4096, lds, S, tid_in);
        cur = nxt;
    }
}
}
namespace gla {
typedef short bf16x8 __attribute__((ext_vector_type(8)));
typedef short s16x4 __attribute__((ext_vector_type(4)));
typedef float f32x16 __attribute__((ext_vector_type(16)));
constexpr int C = 64, DK = 96, DV = 192, NCH = SEQ / C, NUNIT = BATCH * GLA_H * NCH;
constexpr int RP = 208;
constexpr int L_GL = 0, L_WG = 4096, L_BG = 10240, L_CUM = 10752, L_TOT = 35328, L_Q = 36864, L_K = 50176, L_V = 63488, L_PS = 88064, L_RS = 89600, L_R = 89856, L_END = 89856 + 24576;
constexpr int L_Y = L_Q;
__device__ __forceinline__ int crow(int r, int hi) { return (r & 3) + 8 * (r >> 2) + 4 * hi; }
__device__ __forceinline__ float log_sigmoid_fast(float z) { return fminf(z, 0.f) - 0.6931471805599453f * __builtin_amdgcn_logf(1.0f + __builtin_amdgcn_exp2f(-1.4426950408889634f * fabsf(z))); }
__device__ __forceinline__ float exp_fast(float x) { return __builtin_amdgcn_exp2f(1.4426950408889634f * x); }
__device__ __forceinline__ unsigned cvtpk(float lo, float hi) { unsigned r; asm volatile("v_cvt_pk_bf16_f32 %0, %1, %2" : "=v"(r) : "v"(lo), "v"(hi)); return r; }
template <int NCB> __device__ __forceinline__ int tr_st(int k, int c) { const int kk = (k & ~0xC) | ((k & 4) << 1) | ((k & 8) >> 1); return ((kk >> 3) * NCB + (c >> 5)) * 512 + ((kk & 7) * 32 + (c & 31)) * 2; }
__device__ __forceinline__ int tr_rd_base(int lane) { return ((lane & 3) << 3) | (((lane >> 2) & 3) << 6) | (((lane >> 4) & 1) << 5) | (((lane >> 5) & 1) << 8); }
template <int NCB> constexpr int tr_rd_off(int cb, int ks, int half) { return cb * 512 + ks * (2 * NCB * 512) + half * (NCB * 512); }
#define GLA_TRRD(dst, addr, off) asm volatile("ds_read_b64_tr_b16 %0, %1 offset:%2" : "=&v"(dst) : "v"(addr), "i"(off) : "memory")
#define GLA_LWAIT() do { asm volatile("s_waitcnt lgkmcnt(0)" ::: "memory"); __builtin_amdgcn_sched_barrier(0); } while (0)
#define GLA_FRAG(l, h) ((bf16x8){l[0], l[1], l[2], l[3], h[0], h[1], h[2], h[3]})

struct Tens { const bf16* P; const float* wg; const float* bg; const float* ghead; bf16* DS; float* DEC; bf16* SP; bf16* MIX; float* CUM; };

__device__ __forceinline__ void gate_cum(const Tens& T, const v4u w, int h, bool newh, LAS unsigned char* lds, int tid) {
    LAS float* Gl = (LAS float*)(lds + L_GL); LAS float* Wg = (LAS float*)(lds + L_WG); LAS float* Bg = (LAS float*)(lds + L_BG); LAS float* Cum = (LAS float*)(lds + L_CUM); LAS float* Tot = (LAS float*)(lds + L_TOT);
    __syncthreads();
    if (tid < 128) { const int t = tid >> 1, c8 = tid & 1; LAS float* d = Gl + t * 16 + c8 * 8;
        d[0] = bf2f(w.x & 0xffff); d[1] = bf2f(w.x >> 16); d[2] = bf2f(w.y & 0xffff); d[3] = bf2f(w.y >> 16); d[4] = bf2f(w.z & 0xffff); d[5] = bf2f(w.z >> 16); d[6] = bf2f(w.w & 0xffff); d[7] = bf2f(w.w >> 16); }
    if (newh) { for (int idx = tid; idx < 16 * 96; idx += NTHR) Wg[idx] = T.wg[(idx / 96) * GLA_DK + h * 96 + idx % 96];
                if (tid < 96) Bg[tid] = T.bg[h * 96 + tid]; }
    __syncthreads();
    if (tid < 384) { const int seg = tid / 96, d = tid - seg * 96; float w[16];
#pragma unroll
        for (int r = 0; r < 16; ++r) w[r] = Wg[r * 96 + d];
        const float b0 = Bg[d]; float run = 0.f;
        for (int tt = 0; tt < 16; ++tt) { const int t = seg * 16 + tt; float z = b0;
#pragma unroll
            for (int r4 = 0; r4 < 4; ++r4) { const f32x4 g4 = *(const LAS f32x4*)(Gl + t * 16 + r4 * 4); z += g4.x * w[4 * r4] + g4.y * w[4 * r4 + 1] + g4.z * w[4 * r4 + 2] + g4.w * w[4 * r4 + 3]; }
            run += log_sigmoid_fast(z) * (1.0f / 16.0f); Cum[t * 96 + d] = run; }
        Tot[seg * 96 + d] = run; }
    __syncthreads();
    if (tid >= 96 && tid < 384) { const int seg = tid / 96, d = tid - seg * 96; float off = 0.f;
        for (int s = 0; s < seg; ++s) off += Tot[s * 96 + d];
        for (int tt = 0; tt < 16; ++tt) Cum[(seg * 16 + tt) * 96 + d] += off; }
    __syncthreads();
}
__device__ __forceinline__ void unpack8(const v4u w, float (&f)[8]) { f[0] = bf2f(w.x & 0xffff); f[1] = bf2f(w.x >> 16); f[2] = bf2f(w.y & 0xffff); f[3] = bf2f(w.y >> 16); f[4] = bf2f(w.z & 0xffff); f[5] = bf2f(w.z >> 16); f[6] = bf2f(w.w & 0xffff); f[7] = bf2f(w.w >> 16); }

#define GLA_LOADS_A(u_) do { const int bh_ = (u_) / NCH, c_ = (u_) - bh_ * NCH, h_ = bh_ & 3; const size_t r0_ = (size_t)(bh_ >> 2) * SEQ + c_ * C;                                      \
        const GAS unsigned char* pg_ = (const GAS unsigned char*)(T.P + r0_ * NA + PA_GL); const GAS unsigned char* pk_ = (const GAS unsigned char*)(T.P + r0_ * NA + PA_K + h_ * DK);   \
        const GAS unsigned char* pv_ = (const GAS unsigned char*)(T.P + r0_ * NA + PA_V + h_ * DV);                                    \
        if (tid < 128) rgl = *(const GAS v4u*)(pg_ + ogl);                                                                                                                                \
        rk[0] = *(const GAS v4u*)(pk_ + ok_[0]); if (tid < C * (DK / 8) - NTHR) rk[1] = *(const GAS v4u*)(pk_ + ok_[1]);                                                                  \
        _Pragma("unroll") for (int i = 0; i < 3; ++i) rv[i] = *(const GAS v4u*)(pv_ + ov_[i]); } while (0)
__device__ __forceinline__ void phase_a(const Tens& T, int u, const int G, LAS unsigned char* lds, int tid) {
    if (u >= NUNIT) return;
    const int lane = tid & 63, wave = __builtin_amdgcn_readfirstlane(tid >> 6);
    v4u rgl = {0u, 0u, 0u, 0u}, rk[2] = {{0u, 0u, 0u, 0u}, {0u, 0u, 0u, 0u}}, rv[3];
    unsigned ok_[2], ov_[3]; const unsigned ogl = (unsigned)((tid >> 1) * NA + (tid & 1) * 8) * 2u;
#pragma unroll
    for (int i = 0; i < 2; ++i) { const int idx = tid + i * NTHR, t = idx / 12, d8 = idx - t * 12; ok_[i] = (unsigned)(t * NA + d8 * 8) * 2u; }
#pragma unroll
    for (int i = 0; i < 3; ++i) { const int idx = tid + i * NTHR, t = idx / 24, e8 = idx - t * 24; ov_[i] = (unsigned)(t * NA + e8 * 8) * 2u; }
    GLA_LOADS_A(u);
    int hl = -1;
    for (;;) {
        const int bh = u / NCH, h = bh & 3, un = u + G;
        gate_cum(T, rgl, h, h != hl, lds, tid); hl = h;
        LAS float* Cum = (LAS float*)(lds + L_CUM);
#pragma unroll
        for (int i = 0; i < 2; ++i) { const int idx = tid + i * NTHR; if (idx >= C * (DK / 8)) break; const int t = idx / 12, d8 = idx - t * 12; float k[8];
            unpack8(rk[i], k);
            const f32x4 c0 = *(const LAS f32x4*)(Cum + t * 96 + d8 * 8), c1 = *(const LAS f32x4*)(Cum + t * 96 + d8 * 8 + 4), l0 = *(const LAS f32x4*)(Cum + 63 * 96 + d8 * 8), l1 = *(const LAS f32x4*)(Cum + 63 * 96 + d8 * 8 + 4);
            *(GAS f32x4*)(T.CUM + (size_t)u * (C * DK) + t * 96 + d8 * 8) = c0; *(GAS f32x4*)(T.CUM + (size_t)u * (C * DK) + t * 96 + d8 * 8 + 4) = c1;
            v4u o; o.x = cvtpk(k[0] * exp_fast(l0.x - c0.x), k[1] * exp_fast(l0.y - c0.y)); o.y = cvtpk(k[2] * exp_fast(l0.z - c0.z), k[3] * exp_fast(l0.w - c0.w));
            o.z = cvtpk(k[4] * exp_fast(l1.x - c1.x), k[5] * exp_fast(l1.y - c1.y)); o.w = cvtpk(k[6] * exp_fast(l1.z - c1.z), k[7] * exp_fast(l1.w - c1.w));
            *(LAS v4u*)(lds + L_K + tr_st<3>(t, d8 * 8)) = o; }
#pragma unroll
        for (int i = 0; i < 3; ++i) { const int idx = tid + i * NTHR, t = idx / 24, e8 = idx - t * 24; *(LAS v4u*)(lds + L_V + tr_st<6>(t, e8 * 8)) = rv[i]; }
        if (tid < 96) T.DEC[(size_t)u * DK + tid] = exp_fast(Cum[63 * 96 + tid]);
        __syncthreads();
        if (un < NUNIT) GLA_LOADS_A(un);
        if (wave < 6) {
            const int r32 = lane & 31, hi = lane >> 5, vb = L_V + tr_rd_base(lane), kb = L_K + tr_rd_base(lane);
            s16x4 vl[4], vh[4];
#define VRD(ks) do { GLA_TRRD(vl[ks], vb + wave * 512, tr_rd_off<6>(0, ks, 0)); GLA_TRRD(vh[ks], vb + wave * 512, tr_rd_off<6>(0, ks, 1)); } while (0)
            VRD(0); VRD(1); VRD(2); VRD(3);
#undef VRD
            bf16* out = T.DS + (size_t)u * (DV * DK) + (size_t)(wave * 32) * DK + r32;
#define DBLK(db) do { s16x4 kl[4], kh[4]; f32x16 acc = {};                                                                                     \
            GLA_TRRD(kl[0], kb, tr_rd_off<3>(db, 0, 0)); GLA_TRRD(kh[0], kb, tr_rd_off<3>(db, 0, 1)); GLA_TRRD(kl[1], kb, tr_rd_off<3>(db, 1, 0)); GLA_TRRD(kh[1], kb, tr_rd_off<3>(db, 1, 1)); \
            GLA_TRRD(kl[2], kb, tr_rd_off<3>(db, 2, 0)); GLA_TRRD(kh[2], kb, tr_rd_off<3>(db, 2, 1)); GLA_TRRD(kl[3], kb, tr_rd_off<3>(db, 3, 0)); GLA_TRRD(kh[3], kb, tr_rd_off<3>(db, 3, 1)); \
            GLA_LWAIT();                                                                                                                       \
            acc = __builtin_amdgcn_mfma_f32_32x32x16_bf16(GLA_FRAG(vl[0], vh[0]), GLA_FRAG(kl[0], kh[0]), acc, 0, 0, 0);                       \
            acc = __builtin_amdgcn_mfma_f32_32x32x16_bf16(GLA_FRAG(vl[1], vh[1]), GLA_FRAG(kl[1], kh[1]), acc, 0, 0, 0);                       \
            acc = __builtin_amdgcn_mfma_f32_32x32x16_bf16(GLA_FRAG(vl[2], vh[2]), GLA_FRAG(kl[2], kh[2]), acc, 0, 0, 0);                       \
            acc = __builtin_amdgcn_mfma_f32_32x32x16_bf16(GLA_FRAG(vl[3], vh[3]), GLA_FRAG(kl[3], kh[3]), acc, 0, 0, 0);                       \
            _Pragma("unroll") for (int r = 0; r < 16; ++r) { const float nb = __uint_as_float(__builtin_amdgcn_update_dpp(0u, __float_as_uint(acc[r]), 0xB1, 0xf, 0xf, false));     \
                if ((r32 & 1) == 0) *(unsigned*)(out + (size_t)crow(r, hi) * DK + (db) * 32) = cvtpk(acc[r], nb); } } while (0)
            DBLK(0); DBLK(1); DBLK(2);
#undef DBLK
        }
        if (un >= NUNIT) break;
        u = un;
    }
}
#undef GLA_LOADS_A
__device__ __forceinline__ void scan_phase(const Tens& T, int gtid, int nthreads) {
    for (int it = gtid; it < BATCH * GLA_H * DV * (DK / 4); it += nthreads) {
        const int bh = it / (DV * 24), rem = it - bh * (DV * 24), d4 = rem % 24;
        const size_t eoff = (size_t)rem * 4;
        f32x4 S = {0.f, 0.f, 0.f, 0.f};
        const bf16* ds = T.DS + (size_t)bh * NCH * (DV * DK) + eoff; const float* dc = T.DEC + (size_t)bh * NCH * DK + d4 * 4; bf16* sp = T.SP + (size_t)bh * NCH * (DV * DK) + eoff;
#pragma unroll 8
        for (int c = 0; c < NCH; ++c) {
            const unsigned long long dw = *(const GAS unsigned long long*)(ds + (size_t)c * (DV * DK)); const f32x4 a = *(const GAS f32x4*)(dc + c * DK);
            const f32x4 d = {bf2f((unsigned)dw & 0xffff), bf2f(((unsigned)dw) >> 16), bf2f((unsigned)(dw >> 32) & 0xffff), bf2f((unsigned)(dw >> 48))};
            unsigned long long w = (unsigned long long)cvtpk(S.x, S.y) | ((unsigned long long)cvtpk(S.z, S.w) << 32);
            *(GAS unsigned long long*)(sp + (size_t)c * (DV * DK)) = w;
            S = a * S + d; }
    }
}
#define GLA_LOADS_C(u_) do { const int bh_ = (u_) / NCH, c_ = (u_) - bh_ * NCH, h_ = bh_ & 3; const size_t r0_ = (size_t)(bh_ >> 2) * SEQ + c_ * C;                                      \
        const GAS unsigned char* pq_ = (const GAS unsigned char*)(T.P + r0_ * NA + PA_Q + h_ * DK); const GAS unsigned char* pv_ = (const GAS unsigned char*)(T.P + r0_ * NA + PA_V + h_ * DV);   \
        const GAS unsigned char* pc_ = (const GAS unsigned char*)(T.CUM + (size_t)(u_) * (C * DK));                                    \
        rq[0] = *(const GAS v4u*)(pq_ + ok_[0]); rk[0] = *(const GAS v4u*)(pq_ + (PA_K - PA_Q) * 2 + ok_[0]); rc[0][0] = *(const GAS f32x4*)(pc_ + oc_[0]); rc[0][1] = *(const GAS f32x4*)(pc_ + oc_[0] + 16);   \
        if (tid < C * (DK / 8) - NTHR) { rq[1] = *(const GAS v4u*)(pq_ + ok_[1]); rk[1] = *(const GAS v4u*)(pq_ + (PA_K - PA_Q) * 2 + ok_[1]); rc[1][0] = *(const GAS f32x4*)(pc_ + oc_[1]); rc[1][1] = *(const GAS f32x4*)(pc_ + oc_[1] + 16); }   \
        _Pragma("unroll") for (int i = 0; i < 3; ++i) { rv[i] = *(const GAS v4u*)(pv_ + ov_[i]); rr[i] = *(const GAS v4u*)(pv_ + (PA_R - PA_V) * 2 + ov_[i]); } } while (0)
#define GLA_LOADS_SF(u_) do { if (wave < 6) { const bf16* sp0 = T.SP + (size_t)(u_) * (DV * DK) + (size_t)(wave * 32 + (lane & 31)) * DK + 8 * (lane >> 5);                              \
            _Pragma("unroll") for (int ks = 0; ks < 6; ++ks) sf[ks] = *(const GAS bf16x8*)(sp0 + 16 * ks); } } while (0)
#define GLA_C_PREFETCH if (un < NUNIT) GLA_LOADS_C(un);
__device__ __forceinline__ void phase_c(const Tens& T, int u, const int G, LAS unsigned char* lds, int tid) {
    if (u >= NUNIT) return;
    const int lane = tid & 63, wave = __builtin_amdgcn_readfirstlane(tid >> 6);
    bf16x8 sf[6];
#pragma unroll
    for (int ks = 0; ks < 6; ++ks) sf[ks] = (bf16x8){0, 0, 0, 0, 0, 0, 0, 0};
    v4u rq[2] = {{0u, 0u, 0u, 0u}, {0u, 0u, 0u, 0u}}, rk[2] = {{0u, 0u, 0u, 0u}, {0u, 0u, 0u, 0u}}, rv[3], rr[3];
    f32x4 rc[2][2] = {{{0.f, 0.f, 0.f, 0.f}, {0.f, 0.f, 0.f, 0.f}}, {{0.f, 0.f, 0.f, 0.f}, {0.f, 0.f, 0.f, 0.f}}};
    unsigned ok_[2], oc_[2], ov_[3];
#pragma unroll
    for (int i = 0; i < 2; ++i) { const int idx = tid + i * NTHR, t = idx / 12, d8 = idx - t * 12; ok_[i] = (unsigned)(t * NA + d8 * 8) * 2u; oc_[i] = (unsigned)(t * 96 + d8 * 8) * 4u; }
#pragma unroll
    for (int i = 0; i < 3; ++i) { const int idx = tid + i * NTHR, t = idx / 24, e8 = idx - t * 24; ov_[i] = (unsigned)(t * NA + e8 * 8) * 2u; }
    GLA_LOADS_C(u);
    for (;;) {
        const int bh = u / NCH, c = u - bh * NCH, b = bh >> 2, h = bh & 3, un = u + G; const size_t row0 = (size_t)b * SEQ + c * C;
        __syncthreads();
        GLA_LOADS_SF(u);
#pragma unroll
        for (int i = 0; i < 2; ++i) { const int idx = tid + i * NTHR; if (idx >= C * (DK / 8)) break; const int t = idx / 12, d8 = idx - t * 12; float q[8], k[8];
            unpack8(rq[i], q); unpack8(rk[i], k);
            const f32x4 c0 = rc[i][0], c1 = rc[i][1];
            const float e0 = exp_fast(c0.x), e1 = exp_fast(c0.y), e2 = exp_fast(c0.z), e3 = exp_fast(c0.w), e4 = exp_fast(c1.x), e5 = exp_fast(c1.y), e6 = exp_fast(c1.z), e7 = exp_fast(c1.w);
            v4u o; o.x = cvtpk(q[0] * e0, q[1] * e1); o.y = cvtpk(q[2] * e2, q[3] * e3); o.z = cvtpk(q[4] * e4, q[5] * e5); o.w = cvtpk(q[6] * e6, q[7] * e7);
            *(LAS v4u*)(lds + L_Q + t * RP + d8 * 16) = o;
            v4u p; p.x = cvtpk(k[0] * __builtin_amdgcn_rcpf(e0), k[1] * __builtin_amdgcn_rcpf(e1)); p.y = cvtpk(k[2] * __builtin_amdgcn_rcpf(e2), k[3] * __builtin_amdgcn_rcpf(e3));
            p.z = cvtpk(k[4] * __builtin_amdgcn_rcpf(e4), k[5] * __builtin_amdgcn_rcpf(e5)); p.w = cvtpk(k[6] * __builtin_amdgcn_rcpf(e6), k[7] * __builtin_amdgcn_rcpf(e7));
            *(LAS v4u*)(lds + L_K + t * RP + d8 * 16) = p; }
#pragma unroll
        for (int i = 0; i < 3; ++i) { const int idx = tid + i * NTHR, t = idx / 24, e8 = idx - t * 24; *(LAS v4u*)(lds + L_V + tr_st<6>(t, e8 * 8)) = rv[i]; *(LAS v4u*)(lds + L_R + t * 384 + e8 * 16) = rr[i]; }
        __syncthreads();
        const int r32 = lane & 31, hi = lane >> 5;
        f32x16 o0 = {}, o1 = {};
        if (wave < 6) {
            f32x16 p00 = {}, p01 = {}, p11 = {};
            bf16x8 qf0[6], qf1[6];
    #pragma unroll
            for (int ks = 0; ks < 6; ++ks) { qf0[ks] = *(const LAS bf16x8*)(lds + L_Q + r32 * RP + (16 * ks + 8 * hi) * 2); qf1[ks] = *(const LAS bf16x8*)(lds + L_Q + (32 + r32) * RP + (16 * ks + 8 * hi) * 2); }
    #pragma unroll
            for (int ks = 0; ks < 6; ++ks) { const bf16x8 k0 = *(const LAS bf16x8*)(lds + L_K + r32 * RP + (16 * ks + 8 * hi) * 2), k1 = *(const LAS bf16x8*)(lds + L_K + (32 + r32) * RP + (16 * ks + 8 * hi) * 2);
                p00 = __builtin_amdgcn_mfma_f32_32x32x16_bf16(k0, qf0[ks], p00, 0, 0, 0);
                p01 = __builtin_amdgcn_mfma_f32_32x32x16_bf16(k0, qf1[ks], p01, 0, 0, 0);
                p11 = __builtin_amdgcn_mfma_f32_32x32x16_bf16(k1, qf1[ks], p11, 0, 0, 0); }
    #pragma unroll
            for (int r = 0; r < 16; ++r) { if (crow(r, hi) > r32) { p00[r] = 0.f; p11[r] = 0.f; } }
    #pragma unroll
            for (int ks = 0; ks < 6; ++ks) { o0 = __builtin_amdgcn_mfma_f32_32x32x16_bf16(qf0[ks], sf[ks], o0, 0, 0, 0); o1 = __builtin_amdgcn_mfma_f32_32x32x16_bf16(qf1[ks], sf[ks], o1, 0, 0, 0); }
            bf16x8 pa0, pa1, pb0, pb1, pb2, pb3;
    #define PK4(P, B_, OUT) do { unsigned a0 = cvtpk(P[B_+0], P[B_+1]), a1 = cvtpk(P[B_+2], P[B_+3]); unsigned b0 = cvtpk(P[B_+4], P[B_+5]), b1 = cvtpk(P[B_+6], P[B_+7]);          \
            auto r0 = __builtin_amdgcn_permlane32_swap(a0, b0, false, false); auto r1 = __builtin_amdgcn_permlane32_swap(a1, b1, false, false);                                    \
            u32x4 w = {r0[0], r1[0], r0[1], r1[1]}; OUT = *reinterpret_cast<bf16x8*>(&w); } while (0)
            typedef unsigned u32x4 __attribute__((ext_vector_type(4)));
            PK4(p00, 0, pa0); PK4(p00, 8, pa1); PK4(p01, 0, pb0); PK4(p01, 8, pb1); PK4(p11, 0, pb2); PK4(p11, 8, pb3);
    #undef PK4
            const int vb = L_V + tr_rd_base(lane) + wave * 512;
            s16x4 vl[4], vh[4];
            GLA_TRRD(vl[0], vb, tr_rd_off<6>(0, 0, 0)); GLA_TRRD(vh[0], vb, tr_rd_off<6>(0, 0, 1)); GLA_TRRD(vl[1], vb, tr_rd_off<6>(0, 1, 0)); GLA_TRRD(vh[1], vb, tr_rd_off<6>(0, 1, 1));
            GLA_TRRD(vl[2], vb, tr_rd_off<6>(0, 2, 0)); GLA_TRRD(vh[2], vb, tr_rd_off<6>(0, 2, 1)); GLA_TRRD(vl[3], vb, tr_rd_off<6>(0, 3, 0)); GLA_TRRD(vh[3], vb, tr_rd_off<6>(0, 3, 1));
            GLA_LWAIT();
            o0 = __builtin_amdgcn_mfma_f32_32x32x16_bf16(pa0, GLA_FRAG(vl[0], vh[0]), o0, 0, 0, 0); o0 = __builtin_amdgcn_mfma_f32_32x32x16_bf16(pa1, GLA_FRAG(vl[1], vh[1]), o0, 0, 0, 0);
            o1 = __builtin_amdgcn_mfma_f32_32x32x16_bf16(pb0, GLA_FRAG(vl[0], vh[0]), o1, 0, 0, 0); o1 = __builtin_amdgcn_mfma_f32_32x32x16_bf16(pb1, GLA_FRAG(vl[1], vh[1]), o1, 0, 0, 0);
            o1 = __builtin_amdgcn_mfma_f32_32x32x16_bf16(pb2, GLA_FRAG(vl[2], vh[2]), o1, 0, 0, 0); o1 = __builtin_amdgcn_mfma_f32_32x32x16_bf16(pb3, GLA_FRAG(vl[3], vh[3]), o1, 0, 0, 0);
        }
        GLA_C_PREFETCH
        if (wave < 6) {
            float v[32];
    #pragma unroll
            for (int r = 0; r < 16; ++r) { v[r] = o0[r] * o0[r]; v[16 + r] = o1[r] * o1[r]; }
    #define TRED(m, n) do { const bool up = (lane & (m)) != 0; _Pragma("unroll") for (int r = 0; r < (n); ++r) { const float send = up ? v[r] : v[r + (n)], keep = up ? v[r + (n)] : v[r]; v[r] = keep + __shfl_xor(send, (m)); } } while (0)
            TRED(16, 16); TRED(8, 8); TRED(4, 4); TRED(2, 2); TRED(1, 1);
    #undef TRED
            ((LAS float*)(lds + L_PS))[wave * 64 + 32 * (r32 >> 4) + crow(r32 & 15, hi)] = v[0];
        }
        __syncthreads();
        if (tid < 64) { LAS float* ps = (LAS float*)(lds + L_PS); const float s = ((ps[tid] + ps[64 + tid]) + (ps[128 + tid] + ps[192 + tid])) + (ps[256 + tid] + ps[320 + tid]);
            ((LAS float*)(lds + L_RS))[tid] = 1.0f / sqrtf(s * (1.0f / 192.0f) + EPS); }
        __syncthreads();
        if (wave < 6) {
            const LAS float* rs = (const LAS float*)(lds + L_RS) + 4 * hi; const int e = wave * 32 + r32; const float gh = T.ghead[e];
            const LAS bf16* rt = (const LAS bf16*)(lds + L_R) + 4 * hi * 192 + e; LAS bf16* yt = (LAS bf16*)(lds + L_Y) + 4 * hi * 192 + e;
    #pragma unroll
            for (int r = 0; r < 16; ++r) { const int ic = (r & 3) + 8 * (r >> 2);
                const float ra = bf2f(rt[ic * 192]), rb = bf2f(rt[(32 + ic) * 192]);
                const float ya = o0[r] * rs[ic] * gh * (ra * __builtin_amdgcn_rcpf(1.0f + exp_fast(-ra))), yb = o1[r] * rs[32 + ic] * gh * (rb * __builtin_amdgcn_rcpf(1.0f + exp_fast(-rb)));
                yt[ic * 192] = (bf16)f2bf(ya); yt[(32 + ic) * 192] = (bf16)f2bf(yb); }
        }
        __syncthreads();
        for (int idx = tid; idx < C * (DV / 8); idx += NTHR) { const int t = idx / 24, e8 = idx - t * 24;
            *(GAS v4u*)(T.MIX + (row0 + t) * DM + h * DV + e8 * 8) = *(const LAS v4u*)(lds + L_Y + t * 384 + e8 * 16); }

        if (un >= NUNIT) break;
        u = un;
    }
}
#undef GLA_C_PREFETCH
#undef GLA_LOADS_SF
#undef GLA_LOADS_C
}
namespace mema {
typedef short bf16x8 __attribute__((ext_vector_type(8)));
typedef short s16x4 __attribute__((ext_vector_type(4)));
typedef float f32x16 __attribute__((ext_vector_type(16)));
typedef unsigned u32x4 __attribute__((ext_vector_type(4)));
constexpr int L_K = 0, L_V = 32768, L_END = 65536;
#define MEM_KSWZ(row, colB) ((row) * 128 + ((colB) ^ (((row) & 7) << 4)))
struct Tens { const bf16* Q; int qpitch; const bf16* K; const bf16* V; bf16* O; };
__device__ __forceinline__ void stage_kv(const Tens& T, int b, int hh, LAS unsigned char* lds, int tid) {
    for (int idx = tid; idx < MEM_LEN * 8; idx += NTHR) { const int j = idx >> 3, c8 = idx & 7;
        const size_t g = (size_t)(b * MEM_LEN + j) * NMEMKV + hh * MEM_DH + c8 * 8;
        *(LAS v4u*)(lds + L_K + MEM_KSWZ(j, c8 * 16)) = *(const GAS v4u*)(T.K + g);
        *(LAS v4u*)(lds + L_V + gla::tr_st<2>(j, c8 * 8)) = *(const GAS v4u*)(T.V + g); }
}
__device__ __forceinline__ void unit(const Tens& T, int b, int hh, int qb, LAS unsigned char* lds, int tid) {
    const int lane = tid & 63, wave = __builtin_amdgcn_readfirstlane(tid >> 6), r32 = lane & 31, hi = lane >> 5;
    const size_t qrow = (size_t)b * SEQ + qb * 256 + wave * 32;
    bf16x8 qr[4];
#pragma unroll
    for (int ks = 0; ks < 4; ++ks) qr[ks] = *(const GAS bf16x8*)(T.Q + (qrow + r32) * T.qpitch + hh * MEM_DH + 16 * ks + 8 * hi);
    f32x16 p[8];
#pragma unroll
    for (int kb = 0; kb < 8; ++kb) { p[kb] = f32x16{};
#pragma unroll
        for (int ks = 0; ks < 4; ++ks) { const bf16x8 kf = *(const LAS bf16x8*)(lds + L_K + MEM_KSWZ(kb * 32 + r32, (16 * ks + 8 * hi) * 2));
            p[kb] = __builtin_amdgcn_mfma_f32_32x32x16_bf16(kf, qr[ks], p[kb], 0, 0, 0); } }
    float mx = p[0][0];
#pragma unroll
    for (int kb = 0; kb < 8; ++kb)
#pragma unroll
        for (int r = 0; r < 16; ++r) mx = fmaxf(mx, p[kb][r]);
    { auto rr = __builtin_amdgcn_permlane32_swap(__float_as_uint(mx), __float_as_uint(mx), false, false); mx = fmaxf(__uint_as_float(rr[0]), __uint_as_float(rr[1])); }
    const float mL = -mx * 1.4426950408889634f; float ps = 0.f;
#pragma unroll
    for (int kb = 0; kb < 8; ++kb)
#pragma unroll
        for (int r = 0; r < 16; ++r) { const float e = __builtin_amdgcn_exp2f(fmaf(p[kb][r], 1.4426950408889634f, mL)); p[kb][r] = e; ps += e; }
    { auto rr = __builtin_amdgcn_permlane32_swap(__float_as_uint(ps), __float_as_uint(ps), false, false); ps = __uint_as_float(rr[0]) + __uint_as_float(rr[1]); }
    f32x16 o0 = {}, o1 = {};
    const int vb = L_V + gla::tr_rd_base(lane);
#define MPK4(P, B_, OUT) do { unsigned a0 = gla::cvtpk(P[B_+0], P[B_+1]), a1 = gla::cvtpk(P[B_+2], P[B_+3]); unsigned b0 = gla::cvtpk(P[B_+4], P[B_+5]), b1 = gla::cvtpk(P[B_+6], P[B_+7]);   \
        auto r0 = __builtin_amdgcn_permlane32_swap(a0, b0, false, false); auto r1 = __builtin_amdgcn_permlane32_swap(a1, b1, false, false);                                           \
        u32x4 w = {r0[0], r1[0], r0[1], r1[1]}; OUT = *reinterpret_cast<bf16x8*>(&w); } while (0)
#define MPV(kb) do { bf16x8 pa0, pa1; MPK4(p[kb], 0, pa0); MPK4(p[kb], 8, pa1); s16x4 l0, h0, l1, h1, l2, h2, l3, h3;                                                                      \
        GLA_TRRD(l0, vb, gla::tr_rd_off<2>(0, 2 * (kb), 0)); GLA_TRRD(h0, vb, gla::tr_rd_off<2>(0, 2 * (kb), 1)); GLA_TRRD(l1, vb, gla::tr_rd_off<2>(0, 2 * (kb) + 1, 0)); GLA_TRRD(h1, vb, gla::tr_rd_off<2>(0, 2 * (kb) + 1, 1)); \
        GLA_TRRD(l2, vb, gla::tr_rd_off<2>(1, 2 * (kb), 0)); GLA_TRRD(h2, vb, gla::tr_rd_off<2>(1, 2 * (kb), 1)); GLA_TRRD(l3, vb, gla::tr_rd_off<2>(1, 2 * (kb) + 1, 0)); GLA_TRRD(h3, vb, gla::tr_rd_off<2>(1, 2 * (kb) + 1, 1)); \
        GLA_LWAIT();                                                                                                                                                                        \
        o0 = __builtin_amdgcn_mfma_f32_32x32x16_bf16(pa0, GLA_FRAG(l0, h0), o0, 0, 0, 0); o0 = __builtin_amdgcn_mfma_f32_32x32x16_bf16(pa1, GLA_FRAG(l1, h1), o0, 0, 0, 0);                \
        o1 = __builtin_amdgcn_mfma_f32_32x32x16_bf16(pa0, GLA_FRAG(l2, h2), o1, 0, 0, 0); o1 = __builtin_amdgcn_mfma_f32_32x32x16_bf16(pa1, GLA_FRAG(l3, h3), o1, 0, 0, 0); } while (0)
    MPV(0); MPV(1); MPV(2); MPV(3); MPV(4); MPV(5); MPV(6); MPV(7);
#undef MPV
#undef MPK4
    const float inv = 1.0f / ps;
    bf16* op = T.O + qrow * DM + hh * MEM_DH; const int lo = 4 * hi * DM + r32;
#pragma unroll
    for (int r = 0; r < 16; ++r) { const int ic = (r & 3) + 8 * (r >> 2); const float il = __shfl(inv, ic + 4 * hi);
        const float a = o0[r] * il, c = o1[r] * il; const float an = __shfl_xor(a, 1), cn = __shfl_xor(c, 1);
        if ((r32 & 1) == 0) { *(unsigned*)(op + (size_t)ic * DM + lo) = gla::cvtpk(a, an); *(unsigned*)(op + (size_t)ic * DM + lo + 32) = gla::cvtpk(c, cn); } }
}
#ifndef MEM_REP
#define MEM_REP 1
#endif
__device__ __forceinline__ void phase(const Tens& T, int vcu, int G, LAS unsigned char* lds, int tid) {
    int cur = -1;
    for (int u = vcu * 2; u < BATCH * MEM_H * 16; u += 2 * G)
        for (int k = 0; k < 2 * MEM_REP; ++k) { const int uu = u + (k & 1), bhh = uu >> 4, qb = uu & 15;
            if (bhh != cur) { __syncthreads(); stage_kv(T, bhh >> 2, bhh & 3, lds, tid); __syncthreads(); cur = bhh; }
            unit(T, bhh >> 2, bhh & 3, qb, lds, tid); }
    __syncthreads();
}
}
#ifndef PRO_REP_W
#define PRO_REP_W 1
#endif
#ifndef PRO_REP_X
#define PRO_REP_X 1
#endif
#ifndef NULL_EPI
#define NULL_EPI 0
#endif
#ifndef BAR_REP
#define BAR_REP 1
#endif
#ifndef REP_MASK
#define REP_MASK 0x0u
#endif
struct Args { const float* in[19]; float* out; unsigned char* ws; int ph_lo, ph_hi, onelaunch, pad; };
constexpr int I_W1 = (DM / 64) * (NFF1 / 64), I_W2 = (DFF / 64) * (DM / 64), I_WA = (DM / 64) * (NA / 64), I_WB = (DM / 64) * (NB / 64), I_WO = (DM / 64) * (DM / 64), I_WKV = (DM / 64) * (NKV / 64), I_WM1 = (DM / 64) * (512 / 64);
constexpr int STAT_ZERO_F4 = (NSTATS - 1) * M / 2;
constexpr int NITEMS = 8 * I_W1 + 8 * I_W2 + 2 * I_WA + 2 * I_WB + 4 * I_WO + I_WKV + 4 * I_WM1;

__device__ __forceinline__ int lane_now() { int l; asm volatile("v_mbcnt_lo_u32_b32 %0, -1, 0\n\tv_mbcnt_hi_u32_b32 %0, -1, %0" : "=v"(l)); return l; }
template <int OFF> __device__ __forceinline__ unsigned long long karg_u64() {
    unsigned long long v;
    asm volatile("s_load_dwordx2 %0, %1, %2\n\ts_waitcnt lgkmcnt(0)" : "=s"(v) : "s"(__builtin_amdgcn_kernarg_segment_ptr()), "i"(OFF) : "memory");
    return v;
}
#define IN_PTR(i) ((const float*)(const GAS float*)karg_u64<8 * (i)>())
#define OUT_PTR() ((float*)(GAS float*)karg_u64<8 * 19>())
#define WS_PTR() ((unsigned char*)(GAS unsigned char*)karg_u64<8 * 20>())
#define WSP(T, off) ((T*)(WS_PTR() + (off)))
#define STATP(i) (WSP(unsigned long long, WS_STATS) + (size_t)(i) * M)
#define MIXP() ((bf16*)OUT_PTR())
#define HALF_LAYER(l, hf) do { \
            if (hf == 1) { \
                PH_BEGIN(2) \
                    { const bool gla = l < 2; const int N = gla ? NA : NB; \
                      pg8::Gemm g{WSP(bf16, WS_HI), gla ? WSP(bf16, WS_WA) + (size_t)l * NA * DM : WSP(bf16, WS_WB) + (size_t)(l - 2) * NB * DM, M, N, DM}; pg8::StaticOrder S; S.init(M, N, GRID, BX); \
                      pg8::EpiBf16 E{WSP(bf16, WS_R2), N, STATP(1 + 3 * l), gla ? nullptr : WSP(float, WS_N2) + (size_t)(l - 2) * FOX_H * M, 3, M, gla ? A_IN_W : 0}; \
                      pg8::gemm_phase<pg8::EpiBf16, pg8::StaticOrder, true, true, DM>(lds + RING_OFF, g, S, E, TID); } \
                    if (l == 0 && (GRID < 192 || BX >= 128)) {     \
                      pg8::Gemm g{WSP(bf16, WS_MEMN), WSP(bf16, WS_WM), MEMROWS, NMEMKV, DM}; pg8::StaticOrder S; S.init(MEMROWS, NMEMKV, GRID, GRID < 192 ? BX : BX - 128); \
                      pg8::EpiBf16 E{WSP(bf16, WS_MEMKV), NMEMKV, nullptr, nullptr, 0, 0}; \
                      pg8::gemm_phase<pg8::EpiBf16, pg8::StaticOrder, true, true, DM>(lds + RING_OFF, g, S, E, TID); } \
                PH_END                                                       \
                if (l < 2) { \
                    PH_BEGIN(3) \
                        { const gla::Tens T{WSP(bf16, WS_R2), IN_PTR(10) + (size_t)l * GLA_R * GLA_DK, IN_PTR(11) + l * GLA_DK, IN_PTR(12) + l * GLA_DVH, WSP(bf16, WS_R1), WSP(float, WS_R1 + 144 * MiB), WSP(bf16, WS_R1), MIXP(), (float*)((unsigned char*)OUT_PTR() + 64 * MiB)}; \
                          gla::phase_a(T, VCU, GRID, lds, TID); } \
                        { const mema::Tens Tm{WSP(bf16, WS_R2) + PA_QM, NA, WSP(bf16, WS_MEMKV) + l * 512, WSP(bf16, WS_MEMKV) + l * 512 + 256, MIXP() + MAIN_W}; mema::phase(Tm, VCU, GRID, lds, TID); } \
                    PH_END \
                    PH_BEGIN(4) \
                        const gla::Tens T{WSP(bf16, WS_R2), nullptr, nullptr, nullptr, WSP(bf16, WS_R1), WSP(float, WS_R1 + 144 * MiB), WSP(bf16, WS_R1), MIXP(), (float*)((unsigned char*)OUT_PTR() + 64 * MiB)}; \
                        gla::scan_phase(T, VCU * NTHR + TID, GRID * NTHR); \
                    PH_END \
                    PH_BEGIN(15) \
                        const gla::Tens T{WSP(bf16, WS_R2), IN_PTR(10) + (size_t)l * GLA_R * GLA_DK, IN_PTR(11) + l * GLA_DK, IN_PTR(12) + l * GLA_DVH, WSP(bf16, WS_R1), WSP(float, WS_R1 + 144 * MiB), WSP(bf16, WS_R1), MIXP(), (float*)((unsigned char*)OUT_PTR() + 64 * MiB)}; \
                        gla::phase_c(T, VCU, GRID, lds, TID); \
                    PH_END \
                } else { \
                    PH_BEGIN(5) \
                        { const fox::Tensors T{WSP(bf16, WS_R2), WSP(bf16, WS_KV), MIXP(), WSP(float, WS_KBIAS)}; const fox::Plan Pl{WSP(float, WS_N2) + (size_t)(l - 2) * FOX_H * M, WSP(float, WS_KMAX), WSP(float, WS_KBIAS)}; fox::fox_phase((char*)lds, T, Pl, VCU, GRID, TID); } \
                        { const mema::Tens Tm{WSP(bf16, WS_R2) + MAIN_W, NB, WSP(bf16, WS_MEMKV) + l * 512, WSP(bf16, WS_MEMKV) + l * 512 + 256, MIXP() + MAIN_W}; mema::phase(Tm, VCU, GRID, lds, TID); } \
                    PH_END                                                   \
                } \
                PH_BEGIN(6) \
                    pg8::Gemm g{MIXP(), WSP(bf16, WS_WO) + (size_t)l * DM * DM, M, DM, DM}; pg8::StaticOrder S; S.init(M, DM, GRID, BX); \
                    pg8::EpiResidT24 E{rep_ ? MIXP() + (size_t)M * DM : WSP(bf16, WS_HI), rep_ ? WSP(unsigned char, WS_R1) : WSP(unsigned char, WS_LO), DM, 1.0f, rep_ ? nullptr : STATP(2 + 3 * l)}; \
                    pg8::gemm_phase<pg8::EpiResidT24, pg8::StaticOrder, false, true, DM>(lds + RING_OFF, g, S, E, TID); \
                PH_END_L(1)                                                  \
            } \
            PH_BEGIN(8) \
                if (l == 2 && hf == 0 && rep_ == 0) {     \
                    fgate_phase(WSP(bf16, WS_HI), WSP(unsigned char, WS_LO), IN_PTR(14), IN_PTR(16), IN_PTR(17), WSP(float, WS_SMALL), GW, NGW_, LANE); \
                    pg8::Gemm gk{WSP(bf16, WS_HI), WSP(bf16, WS_WKV), M, NKV, DM}; pg8::StaticOrder Sk; Sk.init(M, NKV, GRID, BX); \
                    pg8::EpiBf16 Ek{WSP(bf16, WS_KV), NKV, STATP(6), WSP(float, WS_N2) + (size_t)2 * FOX_H * M, 3, M}; \
                    pg8::gemm_phase<pg8::EpiBf16, pg8::StaticOrder, true, true, DM>(lds + RING_OFF, gk, Sk, Ek, TID); } \
                pg8::Gemm g{WSP(bf16, WS_HI), WSP(bf16, WS_W1) + (size_t)(l * 2 + hf) * NFF1 * DM, M, NFF1, DM}; pg8::StaticOrder S; S.init(M, NFF1, GRID, BX); \
                pg8::EpiSwiGLU E{WSP(bf16, WS_R1), DFF, STATP(hf == 0 ? 3 * l : 2 + 3 * l)}; \
                if (NULL_EPI && rep_) { pg8::EpiNull E0; pg8::gemm_phase<pg8::EpiNull, pg8::StaticOrder, true, true, DM>(lds + RING_OFF, g, S, E0, TID); } \
                else pg8::gemm_phase<pg8::EpiSwiGLU, pg8::StaticOrder, true, true, DM>(lds + RING_OFF, g, S, E, TID); \
            PH_END_L(!(l == 2 && hf == 0))                               \
            PH_BEGIN(9) \
                if (l == 2 && hf == 0 && rep_ == 0) dcum_phase(WSP(float, WS_SMALL), WSP(float, WS_SMALL + 1 * MiB), WSP(float, WS_KBIAS), WSP(float, WS_N2) + (size_t)2 * FOX_H * M, WSP(float, WS_KMAX), GW, NGW_, LANE);     \
                pg8::Gemm g{WSP(bf16, WS_R1), WSP(bf16, WS_W2) + (size_t)(l * 2 + hf) * DM * DFF, M, DM, DFF}; pg8::StaticOrder S; S.init(M, DM, GRID, BX); \
                pg8::EpiResidT24 E{rep_ ? MIXP() : WSP(bf16, WS_HI), rep_ ? (unsigned char*)(MIXP() + (size_t)M * DM) : WSP(unsigned char, WS_LO), DM, 0.5f, rep_ ? nullptr : (hf == 0 ? STATP(1 + 3 * l) : (l < DEPTH - 1 ? STATP(3 + 3 * l) : nullptr))}; \
                if (NULL_EPI && rep_) { pg8::EpiNull E0; pg8::gemm_phase<pg8::EpiNull, pg8::StaticOrder, true, true, DFF>(lds + RING_OFF, g, S, E0, TID); } \
                else pg8::gemm_phase<pg8::EpiResidT24, pg8::StaticOrder, false, true, DFF>(lds + RING_OFF, g, S, E, TID); \
            PH_END_L(hf == 0 || l == 0 || l == 2)                        \
            if (hf == 1 && l == DEPTH - 1) { \
                PH_BEGIN(13) \
                    const RowArgs a{nullptr, WSP(bf16, WS_HI), WSP(unsigned char, WS_LO), IN_PTR(18), nullptr, nullptr, nullptr, nullptr, OUT_PTR(), nullptr, nullptr, nullptr, M}; row_phase(a, GW, NGW_, LANE); \
                PH_END \
            } \
    } while (0)
__global__ void __launch_bounds__(NTHR, 2) yoco_fwd(Args args) {
    extern __shared__ __attribute__((aligned(16))) unsigned char lds_raw[];
    LAS unsigned char* const lds0 = (LAS unsigned char*)lds_raw;
    const int wave_s = __builtin_amdgcn_readfirstlane((int)(threadIdx.x >> 6));
    { const int t0 = wave_s * 64 + lane_now();
      for (int u = t0; u < (LDS_BYTES - LDSCTL_OFF) / 4; u += NTHR) ((LAS unsigned*)(lds0 + LDSCTL_OFF))[u] = 0u;
      __syncthreads();
      if (args.onelaunch) { (void)xcd_barrier_post((unsigned*)(WSP(unsigned, WS_CTL) + CW_BAR), (volatile LAS unsigned*)(lds0 + MISC_OFF) + 8, t0); xcd_local_post((unsigned*)(WSP(unsigned, WS_CTL) + CW_BAR), t0, (int)blockIdx.x); } }
#define TID tid_
#define LANE (tid_ & 63)
#define WAVE (__builtin_amdgcn_readfirstlane(tid_ >> 6))
#define GRID ((int)gridDim.x)
#define BX bx_
#define VCU ((GRID % 8 == 0) ? (BX % 8) * (GRID / 8) + BX / 8 : BX)
#define GW (VCU * NWAVES + WAVE)
#define NGW_ (GRID * NWAVES)
    const int lo = args.ph_lo, hi = args.ph_hi;
    int ph = 0;
#define PH_BEGIN(site) if (ph >= lo && ph < hi) { int tid_ = wave_s * 64 + lane_now(); asm volatile("" : "+v"(tid_)); int bx_ = blockIdx.x; asm volatile("" : "+s"(bx_)); LAS unsigned char* lds = lds0; asm volatile("" : "+s"(lds));     \
    for (int rep_ = 0; rep_ <= (int)((REP_MASK >> (site)) & 1u); ++rep_) {
#define PH_END_L(loc) } if (ph + 1 < hi) { XcdBarrier bar_; bar_.bar = (unsigned*)(WSP(unsigned, WS_CTL) + CW_BAR); bar_.x = xb_xcc_id(); bar_.st = (volatile LAS unsigned*)(lds + MISC_OFF) + 8; if ((loc) && args.onelaunch) xcd_seam(bar_, tid_, bx_, GRID); else xcd_barrier(bar_, tid_); } } ++ph;
#define PH_END   } if (ph + 1 < hi) { XcdBarrier bar_; bar_.bar = (unsigned*)(WSP(unsigned, WS_CTL) + CW_BAR); bar_.x = xb_xcc_id(); bar_.st = (volatile LAS unsigned*)(lds + MISC_OFF) + 8; xcd_barrier(bar_, tid_); if (BAR_REP > 1) xcd_barrier(bar_, tid_); } } ++ph;

    PH_BEGIN(0)
        LAS float* scr = (LAS float*)(lds + RING_OFF + WAVE * 16384);
        for (int it = GW; it < NITEMS * PRO_REP_W; it += NGW_) {
            int r = it % NITEMS;
            if (r < 8 * I_W1) { const int mat = r / I_W1; transpose_item(IN_PTR(3) + (size_t)mat * DM * NFF1, DM, NFF1, NFF1, WSP(bf16, WS_W1) + (size_t)mat * NFF1 * DM, scr, r % I_W1, LANE, IN_PTR(2) + (size_t)mat * DM, MapSwi()); continue; } r -= 8 * I_W1;
            if (r < 8 * I_W2) { const int mat = r / I_W2; transpose_item(IN_PTR(4) + (size_t)mat * DFF * DM, DFF, DM, DM, WSP(bf16, WS_W2) + (size_t)mat * DM * DFF, scr, r % I_W2, LANE, nullptr, MapResid()); continue; } r -= 8 * I_W2;
            if (r < 2 * I_WA) { const int mat = r / I_WA; transpose_item(IN_PTR(9) + (size_t)mat * DM * A_IN_W, DM, A_IN_W, NA, WSP(bf16, WS_WA) + (size_t)mat * NA * DM, scr, r % I_WA, LANE, IN_PTR(5) + (size_t)mat * DM, MapInA()); continue; } r -= 2 * I_WA;
            if (r < 2 * I_WB) { const int mat = r / I_WB; transpose_item(IN_PTR(13) + (size_t)mat * DM * NB, DM, NB, NB, WSP(bf16, WS_WB) + (size_t)mat * NB * DM, scr, r % I_WB, LANE, IN_PTR(5) + (size_t)(2 + mat) * DM, MapInB()); continue; } r -= 2 * I_WB;
            if (r < 4 * I_WO) { const int mat = r / I_WO; transpose_item(IN_PTR(8) + (size_t)mat * DM * DM, DM, DM, DM, WSP(bf16, WS_WO) + (size_t)mat * DM * DM, scr, r % I_WO, LANE, nullptr, MapResid()); continue; } r -= 4 * I_WO;
            if (r < I_WKV) { transpose_item(IN_PTR(15), DM, NKV, NKV, WSP(bf16, WS_WKV), scr, r, LANE, IN_PTR(14), MapPlain()); continue; } r -= I_WKV;
            { const int mat = r / I_WM1; transpose_item(IN_PTR(7) + (size_t)mat * DM * 512, DM, 512, 512, WSP(bf16, WS_WM) + (size_t)mat * 512 * DM, scr, r % I_WM1, LANE, IN_PTR(6) + mat * DM, MapPlain()); }
        }
        { GAS f32x4* z = (GAS f32x4*)STATP(1); for (int i = VCU * NTHR + TID; i < STAT_ZERO_F4; i += GRID * NTHR) z[i] = (f32x4){0.f, 0.f, 0.f, 0.f}; }
        { GAS f32x4* z = (GAS f32x4*)WSP(float, WS_N2); for (int i = VCU * NTHR + TID; i < 3 * FOX_H * M / 4; i += GRID * NTHR) z[i] = (f32x4){0.f, 0.f, 0.f, 0.f}; }
        { const RowArgs a{IN_PTR(1), nullptr, nullptr, nullptr, nullptr, nullptr, nullptr, WSP(bf16, WS_MEMN), nullptr, nullptr, nullptr, nullptr, MEMROWS}; row_phase(a, GW, NGW_, LANE); }
        for (int xr_ = 0; xr_ < PRO_REP_X; ++xr_) { const RowArgs a{IN_PTR(0), nullptr, nullptr, nullptr, WSP(bf16, WS_HI), WSP(unsigned char, WS_LO), STATP(0), nullptr, nullptr, nullptr, nullptr, nullptr, M}; row_phase(a, GW, NGW_, LANE); }
    PH_END

    HALF_LAYER(0, 0); HALF_LAYER(0, 1); HALF_LAYER(1, 0); HALF_LAYER(1, 1); HALF_LAYER(2, 0); HALF_LAYER(2, 1); HALF_LAYER(3, 0); HALF_LAYER(3, 1);
#undef HALF_LAYER
#undef PH_BEGIN
#undef PH_END
}

static int count_phases() { int n = 2; for (int l = 0; l < DEPTH; ++l) n += 7 + (l < 2 ? 2 : 0); return n; }
#ifndef ONE_LAUNCH
#define ONE_LAUNCH 1
#endif
extern "C" void kernel_launch(void* const* d_in, const int* in_sizes, int n_in, void* d_out, int out_size, void* d_ws, size_t ws_size, hipStream_t stream) {
    static int grid = 0;
    if (grid == 0) {
        if (n_in != 19 || in_sizes[0] != M * DM || out_size != M * DM || ws_size < WS_END) { fprintf(stderr, "kernel_launch: unexpected shapes (n_in %d, in0 %d, out %d, ws %zu < %zu); nothing launched\n", n_in, n_in > 0 ? in_sizes[0] : -1, out_size, ws_size, (size_t)WS_END); grid = -1; return; }
        int dev = 0, cus = 0, per_cu = 0;
        if (hipGetDevice(&dev) != hipSuccess || hipDeviceGetAttribute(&cus, hipDeviceAttributeMultiprocessorCount, dev) != hipSuccess) { grid = -1; return; }
        if (hipFuncSetAttribute((const void*)yoco_fwd, hipFuncAttributeMaxDynamicSharedMemorySize, LDS_BYTES) != hipSuccess) { fprintf(stderr, "kernel_launch: hipFuncSetAttribute failed\n"); grid = -1; return; }
        if (hipOccupancyMaxActiveBlocksPerMultiprocessor(&per_cu, (const void*)yoco_fwd, NTHR, LDS_BYTES) != hipSuccess || per_cu < 1) fprintf(stderr, "kernel_launch: occupancy query reports %d\n", per_cu);
        (void)hipGetLastError();
        grid = cus;
    }
    if (grid < 0) return;
    if (hipMemsetAsync((char*)d_ws + WS_CTL, 0, CTL_ZERO_BYTES, stream) != hipSuccess) return;
    Args a{};
    for (int i = 0; i < 19; ++i) a.in[i] = (const float*)d_in[i];
    a.out = (float*)d_out; a.ws = (unsigned char*)d_ws; a.pad = 0;
    const int nph = count_phases();
    if (ONE_LAUNCH) { a.ph_lo = 0; a.ph_hi = nph; a.onelaunch = 1; hipLaunchKernelGGL(yoco_fwd, dim3(grid), dim3(NTHR), LDS_BYTES, stream, a); }
    else for (int p = 0; p < nph; ++p) { a.ph_lo = p; a.ph_hi = p + 1; a.onelaunch = 0; hipLaunchKernelGGL(yoco_fwd, dim3(grid), dim3(NTHR), LDS_BYTES, stream, a); }
}
```

```cpp
#include <hip/hip_runtime.h>
#include <cstdio>
#include <cstdint>
#include <cmath>
namespace pg8 {
#define PG8_LAS __attribute__((address_space(3)))
typedef unsigned short bf16_t;
typedef short bf16x8 __attribute__((ext_vector_type(8)));
typedef float f32x4 __attribute__((ext_vector_type(4)));
typedef unsigned u32x4 __attribute__((ext_vector_type(4)));
constexpr int BM = 256, BK = 64, HALF = 128, HTB = HALF * BK * 2  , STAGE_BYTES = 8 * HTB, NXCD = 8, WGM = 4;

__host__ __device__ __forceinline__ int lds_byte(int r, int c) { const int st = (r >> 4) * 2 + (c >> 5), rr = r & 15, cc = c & 31, ob = rr * 64 + cc * 2; return st * 1024 + (ob ^ (((ob >> 9) & 1) << 5)); }
__host__ __device__ __forceinline__ void stage_rc(int b, int& R, int& C) { const int st = b / 1024, sb = b % 1024, swz = sb ^ (((sb >> 9) & 1) << 5); R = (st >> 1) * 16 + swz / 64; C = (st & 1) * 32 + (swz % 64) / 2; }
__host__ __device__ __forceinline__ int perm32(int rho) { const int n = rho >> 4, i = rho & 15; return 8 * (i >> 2) + 4 * n + (i & 3); }

struct Unit { int pm, pn; };
struct Gemm { const bf16_t* A; const bf16_t* Bt; int M, N, K; };

struct StaticOrder {
    int nM, nN, nwg, G, c;
    __host__ __device__ void init(int M, int N, int G_, int c_) { nM = M / BM; nN = N / BM; nwg = nM * nN; G = G_; c = c_; }
    __host__ __device__ bool next(int i, Unit& u) const {
        const long L = (long)i * G + c; if (L >= nwg) return false;
        int wgid = (int)L; { const int q = nwg / NXCD, r = nwg % NXCD, xcd = wgid % NXCD, off = wgid / NXCD; wgid = (xcd < r ? xcd * (q + 1) : r * (q + 1) + (xcd - r) * q) + off; }
        const int nig = WGM * nN, gid = wgid / nig, fm = gid * WGM, gsz = (nM - fm) < WGM ? (nM - fm) : WGM;
        u.pm = fm + ((wgid % nig) % gsz); u.pn = (wgid % nig) / gsz; return true;
    }
    __device__ __forceinline__ void a_ready(const Unit&) const {}
    __device__ __forceinline__ void done(const Unit&) const {}
};

__device__ __forceinline__ unsigned cvt_pk_bf16(float lo, float hi) { unsigned r; asm volatile("v_cvt_pk_bf16_f32 %0, %1, %2" : "=v"(r) : "v"(lo), "v"(hi)); return r; }
typedef float f32x2 __attribute__((ext_vector_type(2)));
__device__ __forceinline__ float silu_f(float a) { return a * __builtin_amdgcn_rcpf(1.0f + __builtin_amdgcn_exp2f(-1.4426950408889634f * a)); }
struct EpiBf16 {
    static constexpr bool PERM = true, AFTER_DRAIN = false;
    bf16_t* O; int ldc; const unsigned long long* ss;
    float* n2; int n2_tiles, n2_rows; int ncol;
    __device__ __forceinline__ void operator()(const f32x4 (&acc)[2][2][4][2], const Unit& u, int wr, int wc, int fr, int fq) const {
        const int row0 = u.pm * BM + wr * 64 + fr, col0 = u.pn * BM + wc * 32 + 8 * fq;
        float rsv[2][4];
#pragma unroll
        for (int ai = 0; ai < 2; ++ai)
#pragma unroll
            for (int m = 0; m < 4; ++m) rsv[ai][m] = 1.0f;
        if (ss) { unsigned long long sv[2][4];
#pragma unroll
            for (int ai = 0; ai < 2; ++ai)
#pragma unroll
                for (int m = 0; m < 4; ++m) sv[ai][m] = ss[row0 + ai * HALF + m * 16];
#pragma unroll
            for (int ai = 0; ai < 2; ++ai)
#pragma unroll
                for (int m = 0; m < 4; ++m) rsv[ai][m] = __builtin_amdgcn_rsqf((float)sv[ai][m] * (1.0f / (1024.0f * 4294967296.0f)) + 1e-6f); }
#pragma unroll
        for (int ai = 0; ai < 2; ++ai)
#pragma unroll
            for (int m = 0; m < 4; ++m) { bf16_t* rowp = O + (size_t)(row0 + ai * HALF + m * 16) * ldc + col0;
                const float rs = rsv[ai][m];
#pragma unroll
                for (int bj = 0; bj < 2; ++bj) { const f32x4 v0 = acc[ai][bj][m][0] * rs, v1 = acc[ai][bj][m][1] * rs;
                    u32x4 w; w.x = cvt_pk_bf16(v0[0], v0[1]); w.y = cvt_pk_bf16(v0[2], v0[3]); w.z = cvt_pk_bf16(v1[0], v1[1]); w.w = cvt_pk_bf16(v1[2], v1[3]);
                    if (ncol == 0 || col0 + bj * HALF < ncol) *(u32x4*)(rowp + bj * HALF) = w;
                    if (n2 && u.pn < n2_tiles) { float sq = ((v0[0] * v0[0] + v0[1] * v0[1]) + (v0[2] * v0[2] + v0[3] * v0[3])) + ((v1[0] * v1[0] + v1[1] * v1[1]) + (v1[2] * v1[2] + v1[3] * v1[3]));
                        { const auto r = __builtin_amdgcn_permlane16_swap(__float_as_uint(sq), __float_as_uint(sq), false, false); const unsigned ra = r[0], rb = r[1]; sq = __uint_as_float(ra) + __uint_as_float(rb); }
                        { const auto r = __builtin_amdgcn_permlane32_swap(__float_as_uint(sq), __float_as_uint(sq), false, false); const unsigned ra = r[0], rb = r[1]; sq = __uint_as_float(ra) + __uint_as_float(rb); }
                        if (fq == 0) atomicAdd(n2 + (size_t)(2 * u.pn + bj) * n2_rows + row0 + ai * HALF + m * 16, sq); } } }
    }
};
struct EpiSwiGLU {
    static constexpr bool PERM = true, AFTER_DRAIN = false;
    bf16_t* O; int ldc; const unsigned long long* ss;
    __device__ __forceinline__ void operator()(const f32x4 (&acc)[2][2][4][2], const Unit& u, int wr, int wc, int fr, int fq) const {
        const int row0 = u.pm * BM + wr * 64 + fr, col0 = u.pn * HALF + wc * 32 + 8 * fq;
        float rsv[2][4];
        { unsigned long long sv[2][4];
#pragma unroll
            for (int ai = 0; ai < 2; ++ai)
#pragma unroll
                for (int m = 0; m < 4; ++m) sv[ai][m] = ss[row0 + ai * HALF + m * 16];
#pragma unroll
            for (int ai = 0; ai < 2; ++ai)
#pragma unroll
                for (int m = 0; m < 4; ++m) rsv[ai][m] = __builtin_amdgcn_rsqf((float)sv[ai][m] * (1.0f / (1024.0f * 4294967296.0f)) + 1e-6f); }
#pragma unroll
        for (int ai = 0; ai < 2; ++ai)
#pragma unroll
            for (int m = 0; m < 4; ++m) { bf16_t* rowp = O + (size_t)(row0 + ai * HALF + m * 16) * ldc + col0;
                const float rs = rsv[ai][m], r2 = rs * -1.4426950408889634f, rr = rs * rs;
                const f32x4 A0 = acc[ai][0][m][0], A1 = acc[ai][0][m][1], C0 = acc[ai][1][m][0], C1 = acc[ai][1][m][1];
                const f32x4 t0 = A0 * r2, t1 = A1 * r2; f32x4 e0, e1, s0, s1;
#pragma unroll
                for (int e = 0; e < 4; ++e) { e0[e] = __builtin_amdgcn_exp2f(t0[e]); e1[e] = __builtin_amdgcn_exp2f(t1[e]); }
                const f32x4 d0 = e0 + 1.0f, d1 = e1 + 1.0f;
#pragma unroll
                for (int e = 0; e < 4; ++e) { s0[e] = __builtin_amdgcn_rcpf(d0[e]); s1[e] = __builtin_amdgcn_rcpf(d1[e]); }
                const f32x4 y0 = ((A0 * C0) * rr) * s0, y1 = ((A1 * C1) * rr) * s1;
                u32x4 w; w.x = cvt_pk_bf16(y0[0], y0[1]); w.y = cvt_pk_bf16(y0[2], y0[3]); w.z = cvt_pk_bf16(y1[0], y1[1]); w.w = cvt_pk_bf16(y1[2], y1[3]);
                *(u32x4*)rowp = w; }
    }
};
typedef unsigned u32x2 __attribute__((ext_vector_type(2)));
#define PG8_T24_DEC(hwd, lwd, k) __builtin_bit_cast(float, __builtin_amdgcn_perm((hwd), (lwd), (((5u + 2u * ((k) & 1u)) << 24) | ((4u + 2u * ((k) & 1u)) << 16) | (((k) & 3u) << 8) | 0x0cu)))
#ifndef STREAM16
#define STREAM16 1
#endif
struct EpiResidT24 {
    static constexpr bool PERM = true, AFTER_DRAIN = false;
    bf16_t* HI; unsigned char* LO; int ldc; float scale; unsigned long long* ss;
    __device__ __forceinline__ void operator()(const f32x4 (&acc)[2][2][4][2], const Unit& u, int wr, int wc, int fr, int fq) const {
        const int row0 = u.pm * BM + wr * 64 + fr, col0 = u.pn * BM + wc * 64 + 16 * fq;
#if STREAM16
#pragma unroll
        for (int ai = 0; ai < 2; ++ai) {
            u32x4 hw[4][2];
#pragma unroll
            for (int m = 0; m < 4; ++m) { const size_t off = (size_t)(row0 + ai * HALF + m * 16) * ldc + col0; hw[m][0] = *(const u32x4*)(HI + off); hw[m][1] = *(const u32x4*)(HI + off + 8); }
            asm volatile("" ::: "memory");
#pragma unroll
            for (int m = 0; m < 4; ++m) { const size_t off = (size_t)(row0 + ai * HALF + m * 16) * ldc + col0; f32x2 sq2 = {0.f, 0.f};
#pragma unroll
                for (int bj = 0; bj < 2; ++bj) { const u32x4 hw_ = hw[m][bj]; const f32x4 a0 = acc[ai][bj][m][0], a1 = acc[ai][bj][m][1]; u32x4 ho;
#define PG8_BLO(w_) __builtin_bit_cast(float, (w_) << 16)
#define PG8_BHI(w_) __builtin_bit_cast(float, (w_) & 0xffff0000u)
                    const f32x2 v0 = (f32x2){a0[0], a0[1]} * scale + (f32x2){PG8_BLO(hw_.x), PG8_BHI(hw_.x)}, v1 = (f32x2){a0[2], a0[3]} * scale + (f32x2){PG8_BLO(hw_.y), PG8_BHI(hw_.y)};
                    const f32x2 v2 = (f32x2){a1[0], a1[1]} * scale + (f32x2){PG8_BLO(hw_.z), PG8_BHI(hw_.z)}, v3 = (f32x2){a1[2], a1[3]} * scale + (f32x2){PG8_BLO(hw_.w), PG8_BHI(hw_.w)};
                    ho.x = cvt_pk_bf16(v0[0], v0[1]); ho.y = cvt_pk_bf16(v1[0], v1[1]); ho.z = cvt_pk_bf16(v2[0], v2[1]); ho.w = cvt_pk_bf16(v3[0], v3[1]);
                    *(u32x4*)(HI + off + 8 * bj) = ho;
                    sq2 += v0 * v0; sq2 += v1 * v1; sq2 += v2 * v2; sq2 += v3 * v3; }
                if (ss) { float sq = sq2[0] + sq2[1];
                    { const auto r = __builtin_amdgcn_permlane16_swap(__float_as_uint(sq), __float_as_uint(sq), false, false); const unsigned ra = r[0], rb = r[1]; sq = __uint_as_float(ra) + __uint_as_float(rb); }
                    { const auto r = __builtin_amdgcn_permlane32_swap(__float_as_uint(sq), __float_as_uint(sq), false, false); const unsigned ra = r[0], rb = r[1]; sq = __uint_as_float(ra) + __uint_as_float(rb); }
                    if (fq == 0) atomicAdd(ss + row0 + ai * HALF + m * 16, (unsigned long long)(sq * 4294967296.0f)); } }
            asm volatile("" ::: "memory");
        }
#else
#pragma unroll
        for (int ai = 0; ai < 2; ++ai) {
            u32x4 hw[4][2]; u32x4 lw[4];
#pragma unroll
            for (int m = 0; m < 4; ++m) { const size_t off = (size_t)(row0 + ai * HALF + m * 16) * ldc + col0; hw[m][0] = *(const u32x4*)(HI + off); hw[m][1] = *(const u32x4*)(HI + off + 8); lw[m] = *(const u32x4*)(LO + off); }
            asm volatile("" ::: "memory");
#pragma unroll
            for (int m = 0; m < 4; ++m) { const size_t off = (size_t)(row0 + ai * HALF + m * 16) * ldc + col0; float sq = 0.f; u32x4 lo_;
#pragma unroll
                for (int bj = 0; bj < 2; ++bj) { const u32x4 hw_ = hw[m][bj]; const unsigned l0 = bj ? lw[m].z : lw[m].x, l1 = bj ? lw[m].w : lw[m].y;
                    const f32x4 d0 = acc[ai][bj][m][0] * scale, d1 = acc[ai][bj][m][1] * scale; unsigned w[8];
                    w[0] = __builtin_bit_cast(unsigned, PG8_T24_DEC(hw_.x, l0, 0u) + d0[0]) + 0x80u; w[1] = __builtin_bit_cast(unsigned, PG8_T24_DEC(hw_.x, l0, 1u) + d0[1]) + 0x80u;
                    w[2] = __builtin_bit_cast(unsigned, PG8_T24_DEC(hw_.y, l0, 2u) + d0[2]) + 0x80u; w[3] = __builtin_bit_cast(unsigned, PG8_T24_DEC(hw_.y, l0, 3u) + d0[3]) + 0x80u;
                    w[4] = __builtin_bit_cast(unsigned, PG8_T24_DEC(hw_.z, l1, 0u) + d1[0]) + 0x80u; w[5] = __builtin_bit_cast(unsigned, PG8_T24_DEC(hw_.z, l1, 1u) + d1[1]) + 0x80u;
                    w[6] = __builtin_bit_cast(unsigned, PG8_T24_DEC(hw_.w, l1, 2u) + d1[2]) + 0x80u; w[7] = __builtin_bit_cast(unsigned, PG8_T24_DEC(hw_.w, l1, 3u) + d1[3]) + 0x80u;
                    u32x4 ho;
                    ho.x = __builtin_amdgcn_perm(w[1], w[0], 0x07060302u); ho.y = __builtin_amdgcn_perm(w[3], w[2], 0x07060302u); ho.z = __builtin_amdgcn_perm(w[5], w[4], 0x07060302u); ho.w = __builtin_amdgcn_perm(w[7], w[6], 0x07060302u);
                    const unsigned la = __builtin_amdgcn_perm(w[1], w[0], 0x0c0c0501u) | (__builtin_amdgcn_perm(w[3], w[2], 0x0c0c0501u) << 16), lb = __builtin_amdgcn_perm(w[5], w[4], 0x0c0c0501u) | (__builtin_amdgcn_perm(w[7], w[6], 0x0c0c0501u) << 16);
                    if (bj == 0) { lo_.x = la; lo_.y = lb; } else { lo_.z = la; lo_.w = lb; }
                    *(u32x4*)(HI + off + 8 * bj) = ho;
#pragma unroll
                    for (int k = 0; k < 8; ++k) { const float t = __builtin_bit_cast(float, w[k] & 0xffff0000u); sq += t * t; } }
                *(u32x4*)(LO + off) = lo_;
                if (ss) { sq += __shfl_xor(sq, 16); sq += __shfl_xor(sq, 32); if (fq == 0) atomicAdd(ss + row0 + ai * HALF + m * 16, (unsigned long long)(sq * 4294967296.0f)); } }
            asm volatile("" ::: "memory");
        }
#endif
    }
};
struct EpiNull {
    static constexpr bool PERM = true, AFTER_DRAIN = false;
    __device__ __forceinline__ void operator()(const f32x4 (&acc)[2][2][4][2], const Unit& u, int wr, int wc, int fr, int fq) const {
#pragma unroll
        for (int ai = 0; ai < 2; ++ai)
#pragma unroll
            for (int bj = 0; bj < 2; ++bj)
#pragma unroll
                for (int m = 0; m < 4; ++m) asm volatile("" :: "v"(acc[ai][bj][m][0]), "v"(acc[ai][bj][m][1]));
    }
};
template <class Epi, class Sched, bool ALIGN_EPI = false, bool SP2 = false, int KC = 0  >
__device__ __forceinline__ void gemm_phase(PG8_LAS unsigned char* lds, const Gemm g, const Sched& S, const Epi& E, const int tid_in  ) {
    int tid_o = tid_in; asm volatile("" : "+v"(tid_o));
    const int tid = tid_o, wid = __builtin_amdgcn_readfirstlane(tid >> 6), lane = tid & 63, wr = wid >> 2, wc = wid & 3, fr = lane & 15, fq = lane >> 4;
    const int K = KC ? KC : g.K, nt = K / BK;
    unsigned voffA[2], voffB[2];
#pragma unroll
    for (int i = 0; i < 2; ++i) { int R, C; stage_rc(tid * 16 + i * 8192, R, C); const int Rb = Epi::PERM ? ((R & ~31) + perm32(R & 31)) : R;
        voffA[i] = (unsigned)(R * K + C) * 2u; voffB[i] = (unsigned)(Rb * K + C) * 2u; }
    const size_t kstep = (size_t)(BK * 2);
    const size_t hstep = (size_t)HALF * K * 2;
    const size_t tstep = 2 * hstep;
    const unsigned ldsw = (unsigned)wid * 1024u;
    const int aoff = lds_byte(wr * 64 + fr, fq * 8), boff = lds_byte(wc * 32 + fr, fq * 8);
#define PG8_SA(b, h) (((b) * 2 + (h)) * HTB)
#define PG8_SB(b, h) ((4 + (b) * 2 + (h)) * HTB)
#define PG8_STAGE(bufoff, gbase, voff) do { _Pragma("unroll") for (int _i = 0; _i < 2; ++_i) \
        __builtin_amdgcn_global_load_lds((const unsigned*)((const char*)(gbase) + (voff)[_i]), (PG8_LAS unsigned*)(lds + (bufoff) + ldsw + _i * 8192), 16, 0, 0); } while (0)
#define PG8_LDA(dst, b, h) do { _Pragma("unroll") for (int m = 0; m < 4; ++m) _Pragma("unroll") for (int k = 0; k < 2; ++k) dst[m][k] = *(const PG8_LAS bf16x8*)(lds + PG8_SA(b, h) + aoff + m * 2048 + k * 1024); } while (0)
#define PG8_LDB(dst, b, h) do { _Pragma("unroll") for (int n = 0; n < 2; ++n) _Pragma("unroll") for (int k = 0; k < 2; ++k) dst[n][k] = *(const PG8_LAS bf16x8*)(lds + PG8_SB(b, h) + boff + n * 2048 + k * 1024); } while (0)
#define PG8_MMA(ai, bj, At, Bt) do { __builtin_amdgcn_s_setprio(1); _Pragma("unroll") for (int m = 0; m < 4; ++m) _Pragma("unroll") for (int n = 0; n < 2; ++n) _Pragma("unroll") for (int k = 0; k < 2; ++k) \
        acc[ai][bj][m][n] = __builtin_amdgcn_mfma_f32_16x16x32_bf16(Bt[n][k], At[m][k], acc[ai][bj][m][n], 0, 0, 0); __builtin_amdgcn_s_setprio(0); } while (0)
#define PG8_WAIT_V(n) asm volatile("s_waitcnt vmcnt(" #n ")" ::: "memory")
#define PG8_WAIT_L(n) asm volatile("s_waitcnt lgkmcnt(" #n ")" ::: "memory")
#define PG8_BAR __builtin_amdgcn_s_barrier()
#define PG8_SCHED __builtin_amdgcn_sched_barrier(0)
    Unit cur, nxt; int ui = 0;
    if (!S.next(0, cur)) return;
    f32x4 acc[2][2][4][2];
#pragma unroll
    for (int a = 0; a < 2; ++a)
#pragma unroll
        for (int b = 0; b < 2; ++b)
#pragma unroll
            for (int m = 0; m < 4; ++m)
#pragma unroll
                for (int n = 0; n < 2; ++n) acc[a][b][m][n] = (f32x4){0.f, 0.f, 0.f, 0.f};
    bf16x8 At[4][2], B0[2][2], B1[2][2];
    const char* cA = (const char*)g.A + (size_t)cur.pm * tstep; const char* cB = (const char*)g.Bt + (size_t)cur.pn * tstep;
    S.a_ready(cur);
    if constexpr (SP2) {
        PG8_STAGE(PG8_SB(0, 0), cB, voffB); PG8_STAGE(PG8_SB(0, 1), cB + hstep, voffB); PG8_STAGE(PG8_SA(0, 0), cA, voffA); PG8_STAGE(PG8_SA(0, 1), cA + hstep, voffA);
        if (wr == 1) PG8_BAR;
        PG8_WAIT_V(2); PG8_BAR;
        PG8_STAGE(PG8_SB(1, 0), cB + kstep, voffB); PG8_STAGE(PG8_SA(1, 0), cA + kstep, voffA); PG8_STAGE(PG8_SB(1, 1), cB + hstep + kstep, voffB);
        PG8_WAIT_V(6); PG8_BAR;
    } else {
        PG8_STAGE(PG8_SB(0, 0), cB, voffB); PG8_STAGE(PG8_SA(0, 0), cA, voffA); PG8_STAGE(PG8_SB(0, 1), cB + hstep, voffB); PG8_STAGE(PG8_SA(0, 1), cA + hstep, voffA);
        if (wr == 1) PG8_BAR;
        PG8_WAIT_V(4); PG8_BAR;
        PG8_STAGE(PG8_SB(1, 0), cB + kstep, voffB); PG8_STAGE(PG8_SA(1, 0), cA + kstep, voffA); PG8_STAGE(PG8_SB(1, 1), cB + hstep + kstep, voffB);
        PG8_WAIT_V(6); PG8_BAR;
    }
    for (;;) {
        const bool has_next = S.next(ui + 1, nxt);
        const char* nA = has_next ? (const char*)g.A + (size_t)nxt.pm * tstep : cA; const char* nB = has_next ? (const char*)g.Bt + (size_t)nxt.pn * tstep : cB;
        for (int t = 0; t < nt; t += 2) {
            const bool last = (t == nt - 2);
            const char* a1 = cA + (size_t)(t + 1) * kstep;
            const char* a2 = last ? nA : cA + (size_t)(t + 2) * kstep; const char* b2 = last ? nB : cB + (size_t)(t + 2) * kstep;
            const char* a3 = a2 + kstep; const char* b3 = b2 + kstep;
            if (last && has_next) S.a_ready(nxt);
            if constexpr (SP2) {
            PG8_LDB(B0, 0, 0); PG8_LDB(B1, 0, 1); PG8_SCHED; PG8_LDA(At, 0, 0); PG8_STAGE(PG8_SA(1, 1), a1 + hstep, voffA);
            PG8_WAIT_V(8); PG8_WAIT_L(0); PG8_BAR; PG8_MMA(0, 0, At, B0); PG8_MMA(0, 1, At, B1); PG8_BAR; PG8_SCHED;
            PG8_LDA(At, 0, 1); PG8_STAGE(PG8_SB(0, 0), b2, voffB); PG8_STAGE(PG8_SB(0, 1), b2 + hstep, voffB); PG8_STAGE(PG8_SA(0, 0), a2, voffA);
            PG8_WAIT_V(8); PG8_WAIT_L(0); PG8_BAR; PG8_MMA(1, 0, At, B0); PG8_MMA(1, 1, At, B1); PG8_BAR; PG8_SCHED;
            PG8_LDB(B0, 1, 0); PG8_LDB(B1, 1, 1); PG8_SCHED; PG8_LDA(At, 1, 0); PG8_STAGE(PG8_SA(0, 1), a2 + hstep, voffA);
            PG8_WAIT_V(8); PG8_WAIT_L(0); PG8_BAR; PG8_MMA(0, 0, At, B0); PG8_MMA(0, 1, At, B1); PG8_BAR; PG8_SCHED;
            PG8_LDA(At, 1, 1); PG8_STAGE(PG8_SB(1, 0), b3, voffB); PG8_STAGE(PG8_SB(1, 1), b3 + hstep, voffB); PG8_STAGE(PG8_SA(1, 0), a3, voffA);
            PG8_WAIT_V(8); PG8_WAIT_L(0); PG8_BAR; PG8_MMA(1, 0, At, B0); PG8_MMA(1, 1, At, B1); PG8_BAR; PG8_SCHED;
            } else {
            PG8_LDB(B0, 0, 0); PG8_SCHED; PG8_LDA(At, 0, 0); PG8_STAGE(PG8_SA(1, 1), a1 + hstep, voffA);
            PG8_WAIT_L(8); PG8_BAR; PG8_WAIT_L(0); PG8_MMA(0, 0, At, B0); PG8_BAR; PG8_SCHED;
            PG8_LDB(B1, 0, 1); PG8_STAGE(PG8_SB(0, 0), b2, voffB);
            PG8_BAR; PG8_WAIT_L(0); PG8_MMA(0, 1, At, B1); PG8_BAR;
            PG8_LDA(At, 0, 1); PG8_STAGE(PG8_SA(0, 0), a2, voffA);
            PG8_BAR; PG8_WAIT_L(0); PG8_MMA(1, 0, At, B0); PG8_BAR; PG8_SCHED;
            PG8_STAGE(PG8_SB(0, 1), b2 + hstep, voffB);
            PG8_WAIT_V(6); PG8_BAR; PG8_MMA(1, 1, At, B1); PG8_BAR;
            PG8_LDB(B0, 1, 0); PG8_SCHED; PG8_LDA(At, 1, 0); PG8_STAGE(PG8_SA(0, 1), a2 + hstep, voffA);
            PG8_WAIT_L(8); PG8_BAR; PG8_WAIT_L(0); PG8_MMA(0, 0, At, B0); PG8_BAR; PG8_SCHED;
            PG8_LDB(B1, 1, 1); PG8_STAGE(PG8_SB(1, 0), b3, voffB);
            PG8_BAR; PG8_WAIT_L(0); PG8_MMA(0, 1, At, B1); PG8_BAR;
            PG8_LDA(At, 1, 1); PG8_STAGE(PG8_SA(1, 0), a3, voffA);
            PG8_BAR; PG8_WAIT_L(0); PG8_MMA(1, 0, At, B0); PG8_BAR; PG8_SCHED;
            PG8_STAGE(PG8_SB(1, 1), b3 + hstep, voffB);
            PG8_WAIT_V(6); PG8_BAR; PG8_MMA(1, 1, At, B1); PG8_BAR;
            }
        }
        if constexpr (ALIGN_EPI) { if (wr == 0) PG8_BAR; }
        if constexpr (!Epi::AFTER_DRAIN) { E(acc, cur, wr, wc, fr, fq); S.done(cur); }
        if (!has_next) break;
#pragma unroll
        for (int a = 0; a < 2; ++a)
#pragma unroll
            for (int b = 0; b < 2; ++b)
#pragma unroll
                for (int m = 0; m < 4; ++m)
#pragma unroll
                    for (int n = 0; n < 2; ++n) acc[a][b][m][n] = (f32x4){0.f, 0.f, 0.f, 0.f};
        cur = nxt; cA = nA; cB = nB; ++ui;
        if constexpr (ALIGN_EPI) { if (wr == 1) PG8_BAR; }
    }
    PG8_WAIT_V(0);
    if constexpr (!ALIGN_EPI) { if (wr == 0) PG8_BAR; }
    PG8_BAR;
    if constexpr (Epi::AFTER_DRAIN) { E.fused(acc, cur, wr, wc, fr, fq, lds, wid, lane); S.done(cur); }
#undef PG8_SA
#undef PG8_SB
#undef PG8_STAGE
#undef PG8_LDA
#undef PG8_LDB
#undef PG8_MMA
#undef PG8_WAIT_V
#undef PG8_WAIT_L
#undef PG8_BAR
#undef PG8_SCHED
}
}
constexpr int NWAVES = 8, NTHR = 512;
constexpr int BATCH = 8, SEQ = 4096, DM = 1024, DEPTH = 4, M = BATCH * SEQ;
constexpr int DFF = 2816, NFF1 = 2 * DFF;
constexpr int GLA_H = 4, GLA_DK = 384, GLA_DV = 768, GLA_DKH = 96, GLA_DVH = 192, GLA_R = 16;
constexpr int FOX_H = 6, FOX_DH = 128, MAIN_W = 768, MEM_W = 256, MEM_H = 4, MEM_DH = 64, MEM_LEN = 256;
constexpr int A_IN_W = 2576, NA = 2816  , NB = 1024, NKV = 1536;
constexpr int PA_Q = 0, PA_K = 384, PA_V = 768, PA_R = 1536, PA_QM = 2304, PA_GL = 2560;
constexpr float EPS = 1e-6f;
constexpr int MEMROWS = BATCH * MEM_LEN;
constexpr int NMEMKV = DEPTH * 2 * MEM_W;

constexpr size_t MiB = 1u << 20;
constexpr size_t WS_CTL = 0, CTL_ZERO_BYTES = 32768;
constexpr size_t WS_W1 = 1 * MiB;
constexpr size_t WS_W2 = WS_W1 + 88 * MiB;
constexpr size_t WS_WA = WS_W2 + 44 * MiB;
constexpr size_t WS_WB = WS_WA + 11 * MiB;
constexpr size_t WS_WO = WS_WB + 4 * MiB;
constexpr size_t WS_WKV = WS_WO + 8 * MiB;
constexpr size_t WS_WM = WS_WKV + 3 * MiB;
constexpr size_t WS_HI = WS_WM + 4 * MiB;
constexpr size_t WS_LO = WS_HI + 64 * MiB;
constexpr size_t WS_MEMN = WS_LO + 64 * MiB;
constexpr size_t WS_MEMKV = WS_MEMN + 4 * MiB;
constexpr size_t WS_SMALL = WS_MEMKV + 8 * MiB;
constexpr size_t WS_KBIAS = WS_SMALL + 2 * MiB;
constexpr size_t WS_STATS = WS_LO + 32 * MiB;
constexpr int NSTATS = 13;
constexpr size_t WS_N2 = WS_SMALL + 5 * MiB;
constexpr size_t WS_KMAX = WS_SMALL + 1 * MiB + 768 * 1024;
constexpr size_t WS_R1 = WS_SMALL + 8 * MiB;
constexpr size_t WS_R2 = WS_R1 + 176 * MiB;
constexpr size_t WS_KV = WS_R2 + 64 * MiB;
constexpr size_t WS_END = WS_R2 + 176 * MiB;
static_assert(WS_END == 663 * MiB, "ws map");
constexpr int CW_BAR = 4096;

constexpr int RING_OFF = 0, RING_BYTES = 131072;
constexpr int LDSCTL_OFF = RING_BYTES, MISC_OFF = LDSCTL_OFF + 320;
constexpr int LDS_BYTES = 147456;
#define GAS __attribute__((address_space(1)))
#define LAS __attribute__((address_space(3)))
typedef unsigned short bf16;
typedef unsigned v4u __attribute__((ext_vector_type(4)));
typedef float f32x4 __attribute__((ext_vector_type(4)));
typedef short bf16x8 __attribute__((ext_vector_type(8)));
typedef GAS unsigned gu32;
typedef GAS unsigned long long gu64;
#define RLX_AGENT __ATOMIC_RELAXED, __HIP_MEMORY_SCOPE_AGENT
#define LDS_WAIT() asm volatile("s_waitcnt lgkmcnt(0)" ::: "memory")
#define VM_WAIT() asm volatile("s_waitcnt vmcnt(0)" ::: "memory")
__device__ __forceinline__ unsigned long long rt() { return __builtin_amdgcn_s_memrealtime(); }
__device__ __forceinline__ unsigned f2bf(float f) { unsigned u = __builtin_bit_cast(unsigned, f); return (u + 0x7fffu + ((u >> 16) & 1u)) >> 16; }
__device__ __forceinline__ unsigned pk2(float lo, float hi) { return f2bf(lo) | (f2bf(hi) << 16); }

#define XB_TMO      128
#define XB_XCNT(j)  (256  + 64 * (j))
#define XB_XSUB(j)  (1280 + 64 * (j))
#define XB_XGEN(j)  (2304 + 64 * (j))
#define XB_TOP      3328
#define XB_TOPGEN   3392
#define XCD_BAR_WORDS 3456
#define XB_SPIN_CAP (1u << 22)

__device__ __forceinline__ unsigned xb_ld(unsigned* p)              { return __hip_atomic_load(p, __ATOMIC_RELAXED, __HIP_MEMORY_SCOPE_AGENT); }
__device__ __forceinline__ unsigned xb_add(unsigned* p, unsigned v) { return __hip_atomic_fetch_add(p, v, __ATOMIC_RELAXED, __HIP_MEMORY_SCOPE_AGENT); }
__device__ __forceinline__ unsigned xb_xcc_id() { return (unsigned)__builtin_amdgcn_s_getreg((3 << 11) | 20) & 0xFu; }
#define XB_SPIN(cond, bar) do { unsigned _sp = 0; while (cond) { __builtin_amdgcn_s_sleep(1); \
    if ((++_sp & 255u) == 0u) { if (xb_ld(&(bar)[XB_TMO])) break; if (_sp > XB_SPIN_CAP) { atomicAdd(&(bar)[XB_TMO], 1u); break; } } } } while (0)

struct XcdBarrier {
    unsigned* bar; unsigned x;
    volatile LAS unsigned* st;
};

__device__ __forceinline__ XcdBarrier xcd_barrier_post(unsigned* bar, volatile LAS unsigned* st, const int tid_in) {
    XcdBarrier b; b.bar = bar; b.x = xb_xcc_id(); b.st = st;
    if (tid_in == 0) (void)xb_add(&bar[XB_XCNT(b.x)], 1u);
    return b;
}
__device__ __forceinline__ void xcd_barrier_complete(unsigned* bar, unsigned x, unsigned& nloc, unsigned& nx) {
    const unsigned G = gridDim.x * gridDim.y * gridDim.z;
    unsigned sum, cnt, mine, sp = 0u;
    for (;;) {
        sum = 0u; cnt = 0u; mine = 0u;
#pragma unroll
        for (unsigned j = 0; j < 16; ++j) { const unsigned c = xb_ld(&bar[XB_XCNT(j)]); sum += c; cnt += (c > 0u) ? 1u : 0u; mine = (j == x) ? c : mine; }
        if (sum == G) break;
        __builtin_amdgcn_s_sleep(1);
        if ((++sp & 255u) == 0u) { if (xb_ld(&bar[XB_TMO])) break; if (sp > XB_SPIN_CAP) { atomicAdd(&bar[XB_TMO], 1u); break; } }
    }
    nloc = mine > 0u ? mine : 1u; nx = cnt > 0u ? cnt : 1u;
}

__device__ __forceinline__ void xcd_barrier(const XcdBarrier& b, const int tid_in) {
    asm volatile("s_waitcnt vmcnt(0)" ::: "memory");
    __syncthreads();
    if (tid_in == 0) {
        unsigned* bar = b.bar;
        __builtin_amdgcn_s_waitcnt(0);
        unsigned nloc = b.st[0], nx = b.st[1];
        if (nloc == 0u) { xcd_barrier_complete(bar, b.x, nloc, nx); b.st[0] = nloc; b.st[1] = nx; }
        const unsigned old = xb_add(&bar[XB_XSUB(b.x)], 1u);
        const unsigned gen = old / nloc;
        if (old + 1u == (gen + 1u) * nloc) {
            __builtin_amdgcn_fence(__ATOMIC_RELEASE, "agent");
            asm volatile("s_waitcnt vmcnt(0)" ::: "memory");
            const unsigned og = xb_add(&bar[XB_TOP], 1u);
            const unsigned tg = og / nx;
            if (og + 1u == (tg + 1u) * nx) xb_add(&bar[XB_TOPGEN], 1u);
            else XB_SPIN(xb_ld(&bar[XB_TOPGEN]) == tg, bar);
            __builtin_amdgcn_fence(__ATOMIC_ACQUIRE, "agent");
            xb_add(&bar[XB_XGEN(b.x)], 1u);
            asm volatile("s_waitcnt vmcnt(0)" ::: "memory");
        } else {
            XB_SPIN(xb_ld(&bar[XB_XGEN(b.x)]) == gen, bar);
            __builtin_amdgcn_fence(__ATOMIC_ACQUIRE, "agent");
            asm volatile("s_waitcnt vmcnt(0)" ::: "memory");
        }
    }
    __syncthreads();
}

#define XB_GMASK(g) (3456 + 16 * (g))
#define XB_LSUB(g)  (3584 + 32 * (g))
#define XB_LGEN(g)  (3840 + 32 * (g))
__device__ __forceinline__ void xcd_local_post(unsigned* bar, const int tid_in, const int bx) {
    if (tid_in == 0) (void)__hip_atomic_fetch_or(&bar[XB_GMASK(bx & 7)], 1u << xb_xcc_id(), __ATOMIC_RELAXED, __HIP_MEMORY_SCOPE_AGENT);
}
__device__ __forceinline__ void xcd_seam(const XcdBarrier& b, const int tid_in, const int bx, const int G) {
    asm volatile("s_waitcnt vmcnt(0)" ::: "memory");
    if (tid_in == 0 && b.st[2] == 0u) { unsigned ok = (G % 8 == 0) ? 1u : 0u;
#pragma unroll
        for (int g = 0; g < 8; ++g) { const unsigned m = xb_ld(&b.bar[XB_GMASK(g)]); ok = (m != 0u && (m & (m - 1u)) == 0u) ? ok : 0u; }
        b.st[2] = ok ? 1u : 2u; }
    __syncthreads();
    const unsigned mode = b.st[2];
    if (mode != 1u) { xcd_barrier(b, tid_in); return; }
    if (tid_in == 0) {
        unsigned* bar = b.bar; const unsigned g = (unsigned)bx & 7u, n = (unsigned)G / 8u;
        __builtin_amdgcn_s_waitcnt(0);
        const unsigned old = xb_add(&bar[XB_LSUB(g)], 1u);
        const unsigned gen = old / n;
        if (old + 1u == (gen + 1u) * n) xb_add(&bar[XB_LGEN(g)], 1u);
        else XB_SPIN(xb_ld(&bar[XB_LGEN(g)]) == gen, bar);
        __builtin_amdgcn_fence(__ATOMIC_ACQUIRE, "agent");
        asm volatile("s_waitcnt vmcnt(0)" ::: "memory");
    }
    __syncthreads();
}
__device__ __forceinline__ float wave_sum(float v) {
#pragma unroll
    for (int o = 1; o < 64; o <<= 1) v += __shfl_xor(v, o);
    return v;
}
__device__ __forceinline__ float bf2f(bf16 b) { return __builtin_bit_cast(float, (unsigned)b << 16); }
__device__ __forceinline__ float log_sigmoid_f(float z) { return fminf(z, 0.f) - log1pf(expf(-fabsf(z))); }

struct MapPlain { __device__ __forceinline__ void operator()(int r, int& sc, float& cs) const { sc = r; cs = 1.f; } };
struct MapResid { __device__ __forceinline__ void operator()(int r, int& sc, float& cs) const { const int t = r & 255, bj = t >> 7, wc = (t >> 5) & 3, fq = (t >> 3) & 3, lo3 = t & 7; sc = (r & ~255) + 64 * wc + 16 * fq + 8 * bj + lo3; cs = 1.f; } };
struct MapSwi   { __device__ __forceinline__ void operator()(int r, int& sc, float& cs) const { const int pn = r >> 8, x = r & 255; sc = x < 128 ? 128 * pn + x : DFF + 128 * pn + (x - 128); cs = 1.f; } };
struct MapInA   { __device__ __forceinline__ void operator()(int r, int& sc, float& cs) const {
    if (r < PA_QM) { sc = r; cs = r < GLA_DK ? 0.10206207261596575f   : 1.f; }
    else if (r < PA_GL) { sc = r + GLA_R; cs = 0.125f; }
    else if (r < PA_GL + GLA_R) { sc = r - MEM_W; cs = 1.f; }
    else { sc = -1; cs = 0.f; } } };
struct MapInB   { __device__ __forceinline__ void operator()(int r, int& sc, float& cs) const { sc = r; cs = r < MAIN_W ? 1.f : 0.125f; } };
template <class Map>
__device__ __forceinline__ void transpose_item(const float* W, int K, int N, int NR, bf16* WT, LAS float* scr, int item, int lane, const float* kscale, Map map) {
    const int nblk = NR / 64, kb = item / nblk, nb = item - kb * nblk, k0 = 64 * kb, n0 = 64 * nb;
    const int rp = lane >> 4, n4 = lane & 15;
    int sc; float cs; map(n0 + 4 * n4, sc, cs);
    LAS unsigned* T = (LAS unsigned*)scr;
    f32x4 a[8], b[8];
    const float ksv = kscale ? kscale[k0 + lane] : 1.f;
#pragma unroll
    for (int j = 0; j < 8; ++j) { const int kp = 4 * j + rp;
        if (sc >= 0) { a[j] = *(const GAS f32x4*)(W + (size_t)(k0 + 2 * kp) * N + sc); b[j] = *(const GAS f32x4*)(W + (size_t)(k0 + 2 * kp + 1) * N + sc); }
        else { a[j] = (f32x4){0.f, 0.f, 0.f, 0.f}; b[j] = a[j]; } }
    scr[2112 + lane] = ksv;
#pragma unroll
    for (int j = 0; j < 8; ++j) { const int kp = 4 * j + rp; const pg8::f32x2 k2 = *(const LAS pg8::f32x2*)(scr + 2112 + 2 * kp); const float k0_ = k2[0], k1_ = k2[1], sa = cs * k0_, sb = cs * k1_;
        const f32x4 x = a[j] * sa, y = b[j] * sb;
        typedef unsigned u32x2 __attribute__((ext_vector_type(2)));
        LAS u32x2* d = (LAS u32x2*)(T + kp * 66 + 4 * n4);
        d[0] = (u32x2){pg8::cvt_pk_bf16(x.x, y.x), pg8::cvt_pk_bf16(x.y, y.y)}; d[1] = (u32x2){pg8::cvt_pk_bf16(x.z, y.z), pg8::cvt_pk_bf16(x.w, y.w)}; }
    LDS_WAIT(); asm volatile("" ::: "memory");
#pragma unroll
    for (int q = 0; q < 8; ++q) { const int id = q * 64 + lane, n = id >> 3, c = id & 7; const LAS unsigned* s = T + (4 * c) * 66 + n;
        v4u o; o.x = s[0]; o.y = s[66]; o.z = s[132]; o.w = s[198];
        *(GAS v4u*)(WT + (size_t)(n0 + n) * K + k0 + 8 * c) = o; }
    LDS_WAIT(); asm volatile("" ::: "memory");
}

#define T24_DEC(hwd, lwd, k) __builtin_bit_cast(float, __builtin_amdgcn_perm((hwd), (lwd), (((5u + 2u * ((k) & 1u)) << 24) | ((4u + 2u * ((k) & 1u)) << 16) | (((k) & 3u) << 8) | 0x0cu)))
struct RowArgs { const float* src; const bf16* shi; const unsigned char* slo; const float* gain; bf16* hi; unsigned char* lo; unsigned long long* ss; bf16* xn; float* outf; const float* wf; const float* bfg; float* logf; int rows; };
__device__ __forceinline__ void row_phase(const RowArgs& a, int gw, int NGW, int lane) {
    f32x4 nv[4]; unsigned long long nh[4];
#pragma unroll
    for (int j = 0; j < 4; ++j) { nv[j] = (f32x4){0.f, 0.f, 0.f, 0.f}; nh[j] = 0ull; }
#define ROW_LOAD(m_) do { if (a.src) { const GAS f32x4* xr = (const GAS f32x4*)(a.src + (size_t)(m_) * DM) + lane; _Pragma("unroll") for (int j = 0; j < 4; ++j) nv[j] = xr[64 * j]; }    \
        else { const GAS unsigned long long* hr = (const GAS unsigned long long*)(a.shi + (size_t)(m_) * DM) + lane; _Pragma("unroll") for (int j = 0; j < 4; ++j) nh[j] = hr[64 * j]; } } while (0)
    f32x4 gn[4];
#pragma unroll
    for (int j = 0; j < 4; ++j) gn[j] = (a.outf || a.logf) ? ((const GAS f32x4*)a.gain)[lane + 64 * j] : (f32x4){1.f, 1.f, 1.f, 1.f};
    if (gw < a.rows) ROW_LOAD(gw);
    for (int m = gw; m < a.rows; m += NGW) {
        f32x4 v[4]; float s = 0.f;
        if (a.src) {
#pragma unroll
            for (int j = 0; j < 4; ++j) v[j] = nv[j]; }
        else {
#pragma unroll
            for (int j = 0; j < 4; ++j) { const unsigned long long hw = nh[j]; const unsigned h0 = (unsigned)hw, h1 = (unsigned)(hw >> 32);
                v[j].x = __uint_as_float(h0 << 16); v[j].y = __uint_as_float(h0 & 0xffff0000u); v[j].z = __uint_as_float(h1 << 16); v[j].w = __uint_as_float(h1 & 0xffff0000u); } }
        if (m + NGW < a.rows) ROW_LOAD(m + NGW);
#pragma unroll
        for (int j = 0; j < 4; ++j) s += (v[j].x * v[j].x + v[j].y * v[j].y) + (v[j].z * v[j].z + v[j].w * v[j].w);
        s = wave_sum(s);
        if (a.hi) { GAS unsigned long long* ho = (GAS unsigned long long*)(a.hi + (size_t)m * DM) + lane; GAS unsigned* lo = (GAS unsigned*)(a.lo + (size_t)m * DM) + lane; float st = 0.f;
#pragma unroll
            for (int j = 0; j < 4; ++j) { const float fx = v[j].x, fy = v[j].y, fz = v[j].z, fw = v[j].w;
#if STREAM16
                (void)lo; const unsigned p0 = pg8::cvt_pk_bf16(fx, fy), p1 = pg8::cvt_pk_bf16(fz, fw);
                ho[64 * j] = (unsigned long long)p0 | ((unsigned long long)p1 << 32);
                const float t0 = __uint_as_float(p0 << 16), t1 = __uint_as_float(p0 & 0xffff0000u), t2 = __uint_as_float(p1 << 16), t3 = __uint_as_float(p1 & 0xffff0000u);
                st += (t0 * t0 + t1 * t1) + (t2 * t2 + t3 * t3); }
#else
                const unsigned w0 = __float_as_uint(fx) + 0x80u, w1 = __float_as_uint(fy) + 0x80u, w2 = __float_as_uint(fz) + 0x80u, w3 = __float_as_uint(fw) + 0x80u;
                ho[64 * j] = (unsigned long long)__builtin_amdgcn_perm(w1, w0, 0x07060302u) | ((unsigned long long)__builtin_amdgcn_perm(w3, w2, 0x07060302u) << 32);
                lo[64 * j] = __builtin_amdgcn_perm(w1, w0, 0x0c0c0501u) | (__builtin_amdgcn_perm(w3, w2, 0x0c0c0501u) << 16);
                const float t0 = __builtin_bit_cast(float, w0 & 0xffff0000u), t1 = __builtin_bit_cast(float, w1 & 0xffff0000u), t2 = __builtin_bit_cast(float, w2 & 0xffff0000u), t3 = __builtin_bit_cast(float, w3 & 0xffff0000u);
                st += (t0 * t0 + t1 * t1) + (t2 * t2 + t3 * t3); }
#endif
            st = wave_sum(st); if (lane == 0) a.ss[m] = (unsigned long long)(st * 4294967296.0f); }
        const float rstd = 1.0f / sqrtf(s * (1.f / DM) + EPS);
        if (a.xn) { GAS unsigned long long* o8 = (GAS unsigned long long*)(a.xn + (size_t)m * DM) + lane;
#pragma unroll
            for (int j = 0; j < 4; ++j) o8[64 * j] = (unsigned long long)pk2(v[j].x * rstd, v[j].y * rstd) | ((unsigned long long)pk2(v[j].z * rstd, v[j].w * rstd) << 32); }
        if (a.outf || a.logf) {
#pragma unroll
            for (int j = 0; j < 4; ++j) v[j] = v[j] * rstd * gn[j]; }
        if (a.outf) { GAS f32x4* o = (GAS f32x4*)(a.outf + (size_t)m * DM) + lane;
#pragma unroll
            for (int j = 0; j < 4; ++j) __builtin_nontemporal_store(v[j], o + 64 * j); }
        if (a.logf) {
            float z[FOX_H];
#pragma unroll
            for (int h = 0; h < FOX_H; ++h) z[h] = 0.f;
#pragma unroll
            for (int j = 0; j < 4; ++j) { const float* w = a.wf + (size_t)(4 * lane + 256 * j) * FOX_H;
#pragma unroll
                for (int e = 0; e < 4; ++e)
#pragma unroll
                    for (int h = 0; h < FOX_H; ++h) z[h] += v[j][e] * w[e * FOX_H + h]; }
#pragma unroll
            for (int h = 0; h < FOX_H; ++h) { const float t = wave_sum(z[h]) + a.bfg[h]; if (lane == 0) a.logf[(size_t)m * FOX_H + h] = log_sigmoid_f(t); }
        }
    }
}

#undef ROW_LOAD
__device__ __forceinline__ void fgate_phase(const bf16* shi, const unsigned char* slo, const float* gain, const float* wf, const float* bfg, float* logf, int gw, int NGW, int lane) {
    float w[16][FOX_H];
#pragma unroll
    for (int j = 0; j < 4; ++j)
#pragma unroll
        for (int e = 0; e < 4; ++e) { const int c = 4 * lane + 256 * j + e; const float g = gain[c];
#pragma unroll
            for (int h = 0; h < FOX_H; ++h) w[4 * j + e][h] = g * wf[(size_t)c * FOX_H + h]; }
    for (int grp = gw; grp < M / 8; grp += NGW) {
        float v[64];
#pragma unroll
        for (int i = 56; i < 64; ++i) v[i] = 0.f;
#pragma unroll
        for (int r = 0; r < 8; ++r) { const size_t m = (size_t)grp * 8 + r;
            const GAS unsigned long long* hr = (const GAS unsigned long long*)(shi + m * DM) + lane; const GAS unsigned* lr = (const GAS unsigned*)(slo + m * DM) + lane;
            float z[FOX_H], sq = 0.f;
#pragma unroll
            for (int h = 0; h < FOX_H; ++h) z[h] = 0.f;
#pragma unroll
            for (int j = 0; j < 4; ++j) { const unsigned long long hw = hr[64 * j]; const unsigned h0 = (unsigned)hw, h1 = (unsigned)(hw >> 32);
#if STREAM16
                (void)lr; const float x0 = __uint_as_float(h0 << 16), x1 = __uint_as_float(h0 & 0xffff0000u), x2 = __uint_as_float(h1 << 16), x3 = __uint_as_float(h1 & 0xffff0000u);
#else
                const unsigned lw = lr[64 * j]; const float x0 = T24_DEC(h0, lw, 0u), x1 = T24_DEC(h0, lw, 1u), x2 = T24_DEC(h1, lw, 2u), x3 = T24_DEC(h1, lw, 3u);
#endif
                sq += (x0 * x0 + x1 * x1) + (x2 * x2 + x3 * x3);
#pragma unroll
                for (int h = 0; h < FOX_H; ++h) z[h] += (x0 * w[4 * j][h] + x1 * w[4 * j + 1][h]) + (x2 * w[4 * j + 2][h] + x3 * w[4 * j + 3][h]); }
#pragma unroll
            for (int h = 0; h < FOX_H; ++h) v[r * FOX_H + h] = z[h];
            v[48 + r] = sq; }
#define FG_TRED(m_, n_) do { const bool up = (lane & (m_)) != 0; _Pragma("unroll") for (int r = 0; r < (n_); ++r) { const float send = up ? v[r] : v[r + (n_)], keep = up ? v[r + (n_)] : v[r]; v[r] = keep + __shfl_xor(send, (m_)); } } while (0)
        FG_TRED(32, 32); FG_TRED(16, 16); FG_TRED(8, 8); FG_TRED(4, 4); FG_TRED(2, 2); FG_TRED(1, 1);
#undef FG_TRED
        const int r = lane / FOX_H, h = lane - r * FOX_H;
        const float sq = __shfl(v[0], 48 + (r & 7));
        if (lane < 48) { const size_t m = (size_t)grp * 8 + r; const float rstd = 1.0f / sqrtf(sq * (1.f / DM) + EPS);
            logf[m * FOX_H + h] = log_sigmoid_f(v[0] * rstd + bfg[h]); }
    }
}

__device__ __forceinline__ void dcum_phase(const float* logf, float* dcum, float* kbias, const float* kn2, float* kmax, int gw, int NGW, int lane) {
    for (int q = gw; q < BATCH * FOX_H; q += NGW) {
        const int b = q / FOX_H, h = q % FOX_H;
        const float* src = logf + ((size_t)b * SEQ + lane * 64) * FOX_H + h;
        float s = 0.f;
        for (int i = 0; i < 64; ++i) s += src[(size_t)i * FOX_H];
        float inc = s;
#pragma unroll
        for (int o = 1; o < 64; o <<= 1) { const float t = __shfl_up(inc, o); if (lane >= o) inc += t; }
        float run = inc - s;
        float* dst = dcum + (size_t)q * SEQ + lane * 64;
        float* dkb = kbias + (size_t)q * SEQ + lane * 64;
        for (int i = 0; i < 64; ++i) { run += src[(size_t)i * FOX_H]; dst[i] = run; dkb[i] = run * -11.313708498984761f; }
        { const float* kn = kn2 + (size_t)h * M + (size_t)b * SEQ; float mx = 0.f;
#pragma unroll 16
          for (int i = lane; i < SEQ; i += 64) mx = fmaxf(mx, kn[i]);
#pragma unroll
          for (int o = 1; o < 64; o <<= 1) mx = fmaxf(mx, __shfl_xor(mx, o));
          if (lane == 0) kmax[q] = mx; }
    }
}
namespace fox {
constexpr int D = 128, QP = 1024, KVP = 1536, OP = 1024;
constexpr bool WSKIP = false;
constexpr float THR = 8.f;
constexpr float SCALE = 0.08838834764831845f;
constexpr int NW = 8, QBLK = 32, KVBLK = 64, QB = NW * QBLK;
constexpr int SHM_V = KVBLK * D * 2, SHM_K = KVBLK * D * 2;
constexpr int LDS_KB = 2 * SHM_V + 2 * SHM_K + NW * 64 * 4;
constexpr int LDS_BYTES = LDS_KB + 2 * 64 * 4;


using bf16 = unsigned short;
typedef short bf16x8 __attribute__((ext_vector_type(8)));
typedef short s16x4 __attribute__((ext_vector_type(4)));
typedef float f32x16 __attribute__((ext_vector_type(16)));
typedef float f32x4 __attribute__((ext_vector_type(4)));
typedef unsigned u32x4 __attribute__((ext_vector_type(4)));
template <class A, class Bt> struct same_t { static constexpr bool v = false; };
template <class A> struct same_t<A, A> { static constexpr bool v = true; };

#define KSWZ(row, colB) ((row) * 256 + ((colB) ^ (((row) & 7) << 4)))
#define SBAR() __builtin_amdgcn_sched_barrier(0)
__device__ __forceinline__ int v_st(int k, int c) { const int kk = (k & ~0xC) | ((k & 4) << 1) | ((k & 8) >> 1); return ((kk >> 3) * 4 + (c >> 5)) * 512 + ((kk & 7) * 32 + (c & 31)) * 2; }
__device__ __forceinline__ int v_rd_base(int lane) { return ((lane & 3) << 3) | (((lane >> 2) & 3) << 6) | (((lane >> 4) & 1) << 5) | (((lane >> 5) & 1) << 8); }
constexpr int v_rd_off(int d0, int ks, int half) { return d0 * 512 + ks * 4096 + half * 2048; }
__device__ __forceinline__ int crow(int r, int hi) { return (r & 3) + 8 * (r >> 2) + 4 * hi; }
__device__ __forceinline__ unsigned cvtpk(float lo, float hi) {
    unsigned r; asm volatile("v_cvt_pk_bf16_f32 %0, %1, %2" : "=v"(r) : "v"(lo), "v"(hi)); return r;
}
__device__ __forceinline__ bf16x8 pack8(f32x4 a, f32x4 b) {
    u32x4 w = {cvtpk(a[0], a[1]), cvtpk(a[2], a[3]), cvtpk(b[0], b[1]), cvtpk(b[2], b[3])};
    return *reinterpret_cast<bf16x8*>(&w);
}
template <class T> __device__ __forceinline__ bf16x8 load8(const T* p) {
    if constexpr (same_t<T, float>::v) { return pack8(*(const f32x4*)p, *(const f32x4*)(p + 4)); }
    else { return *reinterpret_cast<const bf16x8*>(p); }
}
__device__ __forceinline__ void mask_tile(f32x16& p0, f32x16& p1, int dq, unsigned W) {
    const float NEG = -__builtin_inff();
#pragma unroll
    for (int r = 0; r < 16; ++r) {
        const int c = (r & 3) + 8 * (r >> 2);
        if ((unsigned)(dq - c) >= W) p0[r] = NEG;
        if ((unsigned)(dq - c - 32) >= W) p1[r] = NEG;
    }
}
__device__ __forceinline__ void partialSM(f32x16& p0, f32x16& p1, float& m_reg, float& mn, float& alpha) {
    float pmax = p0[0]; for (int r = 1; r < 16; ++r) pmax = fmaxf(pmax, p0[r]); for (int r = 0; r < 16; ++r) pmax = fmaxf(pmax, p1[r]);
    { auto rr = __builtin_amdgcn_permlane32_swap(__float_as_uint(pmax), __float_as_uint(pmax), false, false);
      pmax = fmaxf(__uint_as_float(rr[0]), __uint_as_float(rr[1])); }
    constexpr float C2 = 1.4426950408889634f * SCALE;
    if (__builtin_expect(__all((pmax - m_reg) * SCALE <= THR), 1)) { mn = m_reg; alpha = 1.f; }
    else { mn = fmaxf(m_reg, pmax); alpha = __builtin_amdgcn_exp2f((m_reg - mn) * C2); m_reg = mn; }
    const float mnL = -mn * C2;
    for (int r = 0; r < 16; ++r) p0[r] = fmaf(p0[r], C2, mnL); for (int r = 0; r < 16; ++r) p1[r] = fmaf(p1[r], C2, mnL);
    for (int r = 0; r < 16; ++r) p0[r] = __builtin_amdgcn_exp2f(p0[r]);
}
__device__ __forceinline__ void finishSM(f32x16& p0, f32x16& p1, float alpha, float& l_reg, bf16x8& pa0, bf16x8& pa1, bf16x8& pa2, bf16x8& pa3) {
    for (int r = 0; r < 16; ++r) p1[r] = __builtin_amdgcn_exp2f(p1[r]);
    float ps = 0; for (int r = 0; r < 16; ++r) ps += p0[r]; for (int r = 0; r < 16; ++r) ps += p1[r];
    { auto rr = __builtin_amdgcn_permlane32_swap(__float_as_uint(ps), __float_as_uint(ps), false, false);
      ps = __uint_as_float(rr[0]) + __uint_as_float(rr[1]); }
    l_reg = l_reg * alpha + ps;
#define PK4(P, B_, OUT) do { unsigned a0 = cvtpk(P[B_+0], P[B_+1]), a1 = cvtpk(P[B_+2], P[B_+3]);                          \
        unsigned b0 = cvtpk(P[B_+4], P[B_+5]), b1 = cvtpk(P[B_+6], P[B_+7]);                                             \
        auto r0 = __builtin_amdgcn_permlane32_swap(a0, b0, false, false); auto r1 = __builtin_amdgcn_permlane32_swap(a1, b1, false, false); \
        u32x4 w = {r0[0], r1[0], r0[1], r1[1]}; OUT = *reinterpret_cast<bf16x8*>(&w); } while (0)
    PK4(p0, 0, pa0); PK4(p0, 8, pa1); PK4(p1, 0, pa2); PK4(p1, 8, pa3);
#undef PK4
}
template <int KB, bool SK>
__device__ __forceinline__ void qkt(f32x16& p0, f32x16& p1, const char* K_lds, const float* kbl, int r32, int hi, const bf16x8* qr, bool act) {
    if (SK && !act) { const float NEG = -__builtin_inff();
#pragma unroll
        for (int r = 0; r < 16; ++r) { p0[r] = NEG; p1[r] = NEG; } return; }
    {
        const float* kb_ = kbl + KB * 64 + 4 * hi;
#pragma unroll
        for (int g_ = 0; g_ < 4; ++g_) { const f32x4 a_ = *(const f32x4*)(kb_ + 8 * g_), b_ = *(const f32x4*)(kb_ + 32 + 8 * g_);
            p0[4 * g_] = a_[0]; p0[4 * g_ + 1] = a_[1]; p0[4 * g_ + 2] = a_[2]; p0[4 * g_ + 3] = a_[3]; p1[4 * g_] = b_[0]; p1[4 * g_ + 1] = b_[1]; p1[4 * g_ + 2] = b_[2]; p1[4 * g_ + 3] = b_[3]; } }
    const char* kb[4];
#pragma unroll
    for (int dd = 0; dd < 4; ++dd) kb[dd] = K_lds + KB * SHM_K + KSWZ(r32, (dd * 16 + hi * 8) * 2);
#pragma unroll
    for (int d0 = 0; d0 < 8; ++d0) { const char* a = kb[d0 & 3] + (d0 >> 2) * 128;
        bf16x8 b0 = *reinterpret_cast<const bf16x8*>(a);
        bf16x8 b1 = *reinterpret_cast<const bf16x8*>(a + 32 * 256);
        p0 = __builtin_amdgcn_mfma_f32_32x32x16_bf16(b0, qr[d0], p0, 0, 0, 0);
        p1 = __builtin_amdgcn_mfma_f32_32x32x16_bf16(b1, qr[d0], p1, 0, 0, 0); }
}
template <int VB, bool SK>
__device__ __forceinline__ void pv_tile(f32x16* o, int vb0, bf16x8 pa0, bf16x8 pa1, bf16x8 pa2, bf16x8 pa3, bool act) {
    if (SK && !act) return;
#define TRRD(dst, off) asm volatile("ds_read_b64_tr_b16 %0, %1 offset:%2" : "=&v"(dst) : "v"(vb0), "i"(off) : "memory")
#define PV_D0(d0) do { s16x4 l0, l1, l2, l3, h0, h1, h2, h3; constexpr int b_ = VB * SHM_V + v_rd_off(d0, 0, 0);     \
        TRRD(l0, b_); TRRD(h0, b_ + 2048); TRRD(l1, b_ + 4096); TRRD(h1, b_ + 6144); TRRD(l2, b_ + 8192); TRRD(h2, b_ + 10240); TRRD(l3, b_ + 12288); TRRD(h3, b_ + 14336); \
        asm volatile("s_waitcnt lgkmcnt(0)" ::: "memory"); SBAR();                 \
        o[d0] = __builtin_amdgcn_mfma_f32_32x32x16_bf16(pa0, (bf16x8){l0[0], l0[1], l0[2], l0[3], h0[0], h0[1], h0[2], h0[3]}, o[d0], 0, 0, 0);   \
        o[d0] = __builtin_amdgcn_mfma_f32_32x32x16_bf16(pa1, (bf16x8){l1[0], l1[1], l1[2], l1[3], h1[0], h1[1], h1[2], h1[3]}, o[d0], 0, 0, 0);   \
        o[d0] = __builtin_amdgcn_mfma_f32_32x32x16_bf16(pa2, (bf16x8){l2[0], l2[1], l2[2], l2[3], h2[0], h2[1], h2[2], h2[3]}, o[d0], 0, 0, 0);   \
        o[d0] = __builtin_amdgcn_mfma_f32_32x32x16_bf16(pa3, (bf16x8){l3[0], l3[1], l3[2], l3[3], h3[0], h3[1], h3[2], h3[3]}, o[d0], 0, 0, 0); } while (0)
    PV_D0(0); PV_D0(1); PV_D0(2); PV_D0(3);
#undef PV_D0
#undef TRRD
}

struct Tensors { const bf16* Qp; const bf16* KVp; bf16* Op; const float* KBp; };
template <class TIn, class TOut> struct BlockRef { int qo, kv, kb, P0; };
template <class TIn> struct Seam {
    bf16x8 qr[8];
    bf16x8 st_v0, st_v1, st_k0, st_k1; f32x4 sf0, sf1, sf2, sf3;
    float st_b;
    f32x4 tq[16];
};
__device__ __forceinline__ int swa_jlo(int P0, int W) { const int lowk = P0 - W + 1; return lowk > 0 ? lowk / KVBLK : 0; }
#define ROW(p, k0, rr) ((p) + (size_t)((k0) + (rr)) * KVP + sc)
#define VMW() asm volatile("s_waitcnt vmcnt(0)" ::: "memory")
#define VMWN(n) asm volatile("s_waitcnt vmcnt(%0)" :: "i"(n) : "memory")
#define SLOAD_H(Kp, Vp, KBp, k0, bb) do { S.st_v0 = load8<TIn>(ROW(Vp, k0, sr)); S.st_v1 = load8<TIn>(ROW(Vp, k0, 32 + sr));              \
                         S.st_k0 = load8<TIn>(ROW(Kp, k0, sr)); S.st_k1 = load8<TIn>(ROW(Kp, k0, 32 + sr));                              \
                         S.st_b = (KBp)[(k0) + lane]; (void)(bb); } while (0)
#define SWRITE_HK(bf) do { *(bf16x8*)(K_lds + (bf) * SHM_K + kws) = S.st_k0; *(bf16x8*)(K_lds + (bf) * SHM_K + kws + 32 * 256) = S.st_k1; kb_lds[(bf) * 64 + lane] = S.st_b; } while (0)
#define SWRITE_HV(bf) do { *(bf16x8*)(V_lds + (bf) * SHM_V + vst0) = S.st_v0; *(bf16x8*)(V_lds + (bf) * SHM_V + vst1) = S.st_v1; } while (0)
#define SWRITE_H(bf) do { SWRITE_HV(bf); SWRITE_HK(bf); } while (0)
#define SLOAD_F(p, k0) do { S.sf0 = *(const f32x4*)ROW(p, k0, sr); S.sf1 = *(const f32x4*)(ROW(p, k0, sr) + 4);                \
                            S.sf2 = *(const f32x4*)ROW(p, k0, 32 + sr); S.sf3 = *(const f32x4*)(ROW(p, k0, 32 + sr) + 4); } while (0)
#define SWRITE_KF(bf) do { *(bf16x8*)(K_lds + (bf) * SHM_K + kws) = pack8(S.sf0, S.sf1); *(bf16x8*)(K_lds + (bf) * SHM_K + kws + 32 * 256) = pack8(S.sf2, S.sf3); } while (0)
#define SWRITE_VF(bf) do { *(bf16x8*)(V_lds + (bf) * SHM_V + vst0) = pack8(S.sf0, S.sf1); *(bf16x8*)(V_lds + (bf) * SHM_V + vst1) = pack8(S.sf2, S.sf3); } while (0)
template <class TIn, class TOut>
__device__ __forceinline__ void causal_swa_prime(const Tensors& T, const BlockRef<TIn, TOut>& cur, int W, char* lds, Seam<TIn>& S, const int tid_in) {
    constexpr bool F32 = same_t<TIn, float>::v;
    int tid_o = tid_in; asm volatile("" : "+v"(tid_o)); const int tid = tid_o, wid = __builtin_amdgcn_readfirstlane(tid >> 6), lane = tid & 63, r32 = lane & 31, hi = lane >> 5;
    const int sr = tid >> 4, sc = (tid & 15) * 8, kws = KSWZ(sr, sc * 2); char* K_lds = lds + 2 * SHM_V; float* kb_lds = (float*)(lds + LDS_KB);
    const int kb0 = (cur.P0 & 255) * KVBLK; (void)W;
    for (int d0 = 0; d0 < 8; ++d0) S.qr[d0] = load8<TIn>((T.Qp + cur.qo) + (size_t)(wid * QBLK + r32) * QP + d0 * 16 + hi * 8);
    if constexpr (F32) { SLOAD_F((const float*)(T.KVp + cur.kv), kb0); VMW(); SWRITE_KF(0); SBAR(); SLOAD_F((const float*)(T.KVp + cur.kv + 768), kb0); }
    else { SLOAD_H((T.KVp + cur.kv), (T.KVp + cur.kv + 768), (T.KBp + cur.kb), kb0, 0); VMW(); SWRITE_HK(0); }
    __syncthreads();
}
template <class TIn, class TOut>
__device__ __forceinline__ void causal_swa_block(const Tensors& T, const BlockRef<TIn, TOut>& cur, const BlockRef<TIn, TOut>& nxt, int skv, int W, char* lds, Seam<TIn>& S, const int tid_in) {
    constexpr bool F32 = same_t<TIn, float>::v;
    int tid_o = tid_in; asm volatile("" : "+v"(tid_o)); const int tid = tid_o, wid = __builtin_amdgcn_readfirstlane(tid >> 6), lane = tid & 63, r32 = lane & 31, hi = lane >> 5;
    const int j_lo = cur.P0 & 255, P0c = cur.P0 & ~255;
    int j_hi = (P0c + QB - 1) / KVBLK + 1; if (j_hi > skv / KVBLK) j_hi = skv / KVBLK;
    const int NT = j_hi - j_lo;
    const int kbn = (nxt.P0 & 255) * KVBLK;
    const int qlo = P0c + wid * QBLK, qm = qlo + r32 - 4 * hi;
    char* V_lds = lds; char* K_lds = lds + 2 * SHM_V; float* kb_lds = (float*)(lds + LDS_KB);
    float* ws = (float*)(lds + 2 * SHM_V + 2 * SHM_K) + wid * 64; float* li_l = ws, * al_l = ws + 32;
    float m_reg = -1e30f, l_reg = 0; f32x16 o[4] = {};
    const int sr = tid >> 4, sc = (tid & 15) * 8, vst0 = v_st(sr, sc), vst1 = v_st(32 + sr, sc), kws = KSWZ(sr, sc * 2);
    const int vb0 = (int)(uintptr_t)V_lds + v_rd_base(lane);
    const TIn* Kh = (T.KVp + cur.kv); const TIn* Vh = (T.KVp + cur.kv + 768); const float* KBh = (T.KBp + cur.kb);
#define RESC(a) do { if (__any((a) < 1.f)) { if (hi == 0) al_l[r32] = (a); asm volatile("s_waitcnt lgkmcnt(0)" ::: "memory");              \
                     for (int d_ = 0; d_ < 4; ++d_) for (int r = 0; r < 16; ++r) o[d_][r] *= al_l[crow(r, hi)]; } } while (0)
#define KBASE(t) ((j_lo + (t)) * KVBLK)
#define ACT(t) (KBASE(t) <= qlo + QBLK - 1 && KBASE(t) + KVBLK - 1 >= qlo - W + 1)
#define MASKT(P0_, P1_, t) do { const int kb_ = KBASE(t); if ((!SK || ACT(t)) && (kb_ + KVBLK - 1 > qlo || kb_ <= qlo + QBLK - 1 - W)) mask_tile(P0_, P1_, qm - kb_, (unsigned)W); } while (0)
    constexpr int NQL = F32 ? 16 : 8;
    constexpr bool SK = WSKIP && !F32;
#define SEAM_K0() do { VMWN(NQL); if constexpr (F32) { SWRITE_KF(0); SBAR(); SLOAD_F((const float*)(T.KVp + nxt.kv + 768), kbn); } else { SWRITE_HK(0); } SBAR(); } while (0)
    f32x16 pA0, pA1, pB0, pB1; float mnA, mnB, alA, alB; bf16x8 pa0, pa1, pa2, pa3;
    if constexpr (F32) { VMW(); SWRITE_VF(0); SBAR(); } else { SWRITE_HV(0); SBAR(); }
    if (NT > 1) { if constexpr (F32) SLOAD_F((const float*)Kh, KBASE(1)); else SLOAD_H(Kh, Vh, KBh, KBASE(1), 1); }
    SBAR(); qkt<0, SK>(pA0, pA1, K_lds, kb_lds, r32, hi, S.qr, ACT(0));
    if constexpr (F32) { if (NT > 1) { VMW(); SWRITE_KF(1); SBAR(); SLOAD_F((const float*)Vh, KBASE(1)); } }
    MASKT(pA0, pA1, 0); partialSM(pA0, pA1, m_reg, mnA, alA);
    if (NT > 1) { VMW(); if constexpr (F32) { SWRITE_VF(1); SBAR(); if (NT > 2) SLOAD_F((const float*)Kh, KBASE(2)); } else SWRITE_H(1); }
    __syncthreads();
#define HALF_STEP(PX0, PX1, mnX, alX, PY0, PY1, alY, t, KB, VB, SB) do {                                                      \
        SBAR(); qkt<KB, SK>(PX0, PX1, K_lds, kb_lds, r32, hi, S.qr, ACT(t));                                             \
        finishSM(PY0, PY1, alY, l_reg, pa0, pa1, pa2, pa3); SBAR();                                                           \
        if ((t) + 1 < NT) { if constexpr (F32) { VMW(); SWRITE_KF(SB); SBAR(); SLOAD_F((const float*)Vh, KBASE((t) + 1)); }  \
                            else { SLOAD_H(Kh, Vh, KBh, KBASE((t) + 1), SB); } SBAR(); }                                               \
        pv_tile<VB, SK>(o, vb0, pa0, pa1, pa2, pa3, ACT((t) - 1)); MASKT(PX0, PX1, (t)); partialSM(PX0, PX1, m_reg, mnX, alX);                                        \
        __syncthreads();                                                                                                      \
        if ((t) + 1 < NT) { VMW(); if constexpr (F32) { SWRITE_VF(SB); SBAR(); if ((t) + 2 < NT) SLOAD_F((const float*)Kh, KBASE((t) + 2)); } \
                            else { SWRITE_H(SB); } }                                                                          \
        RESC(alX); __syncthreads(); } while (0)
    for (int t = 1; t + 1 < NT; t += 2) {
        HALF_STEP(pB0, pB1, mnB, alB, pA0, pA1, alA, t, 1, 0, 0);
        HALF_STEP(pA0, pA1, mnA, alA, pB0, pB1, alB, t + 1, 0, 1, 1);
    }
    const bool even = (NT & 1) == 0;
    if (even) { SBAR(); qkt<1, SK>(pB0, pB1, K_lds, kb_lds, r32, hi, S.qr, ACT(NT - 1)); SBAR(); }
#define QROW(e) ((T.Qp + nxt.qo) + (size_t)(wid * QBLK + r32) * QP + ((e) >> 1) * 16 + hi * 8 + ((e) & 1) * 4)
    if constexpr (F32) { SLOAD_F((const float*)(T.KVp + nxt.kv), kbn); SBAR();
#pragma unroll
        for (int e = 0; e < 8; ++e) S.tq[e] = *(const f32x4*)QROW(e); }
    else { SLOAD_H((T.KVp + nxt.kv), (T.KVp + nxt.kv + 768), (T.KBp + nxt.kb), kbn, 0); SBAR();
#pragma unroll
        for (int d0 = 0; d0 < 8; ++d0) S.qr[d0] = load8<TIn>((T.Qp + nxt.qo) + (size_t)(wid * QBLK + r32) * QP + d0 * 16 + hi * 8); }
    SBAR();
    finishSM(pA0, pA1, alA, l_reg, pa0, pa1, pa2, pa3); SBAR();
    if constexpr (F32) {
#pragma unroll
        for (int e = 8; e < 16; ++e) S.tq[e] = *(const f32x4*)QROW(e); SBAR(); }
#undef QROW
    pv_tile<0, SK>(o, vb0, pa0, pa1, pa2, pa3, ACT(even ? NT - 2 : NT - 1));
    if (even) { MASKT(pB0, pB1, NT - 1); partialSM(pB0, pB1, m_reg, mnB, alB); __syncthreads(); RESC(alB);
        finishSM(pB0, pB1, alB, l_reg, pa0, pa1, pa2, pa3); SBAR(); pv_tile<1, SK>(o, vb0, pa0, pa1, pa2, pa3, ACT(NT - 1)); }
    SBAR(); SEAM_K0();
    if (hi == 0) li_l[r32] = l_reg; asm volatile("s_waitcnt lgkmcnt(0)" ::: "memory");
    float rli[16];
#pragma unroll
    for (int r = 0; r < 16; ++r) rli[r] = __builtin_amdgcn_rcpf(li_l[crow(r, hi)]);
    TOut* Ow = (T.Op + cur.qo) + (size_t)(wid * QBLK) * OP;
#pragma unroll
    for (int r = 0; r < 16; ++r) { const int orow = crow(r, hi);
#pragma unroll
        for (int d0 = 0; d0 < 4; ++d0) { const float v = o[d0][r] * rli[r];
            if constexpr (same_t<TOut, float>::v) { Ow[(size_t)orow * OP + d0 * 32 + r32] = v; }
            else { const float vn = __uint_as_float(__builtin_amdgcn_update_dpp(0u, __float_as_uint(v), 0xB1  , 0xf, 0xf, false));
                   if ((r32 & 1) == 0) *(unsigned*)(Ow + (size_t)orow * OP + d0 * 32 + r32) = cvtpk(v, vn); } } }
    if constexpr (F32) {
#pragma unroll
        for (int d0 = 0; d0 < 8; ++d0) S.qr[d0] = pack8(S.tq[2 * d0], S.tq[2 * d0 + 1]); }
    __syncthreads();
#undef RESC
#undef KBASE
#undef ACT
#undef MASKT
#undef SEAM_K0
#undef HALF_STEP
}
#undef ROW
#undef VMW
#undef VMWN
#undef SLOAD_H
#undef SWRITE_HK
#undef SWRITE_HV
#undef SWRITE_H
#undef SLOAD_F
#undef SWRITE_KF
#undef SWRITE_VF

typedef BlockRef<bf16, bf16> Ref;
struct Plan { const float* qn2; const float* kmax; const float* kb; };
__device__ __forceinline__ int block_jlo(const Plan& P, int bh, int qb, int lane) {
    const int b = bh / 6, h = bh - 6 * b, P0 = qb * QB;
    const float* qn = P.qn2 + (size_t)h * 32768 + (size_t)b * 4096 + P0;
    float q2 = fmaxf(fmaxf(qn[lane], qn[lane + 64]), fmaxf(qn[lane + 128], qn[lane + 192]));
#pragma unroll
    for (int o = 1; o < 64; o <<= 1) q2 = fmaxf(q2, __shfl_xor(q2, o));
    const float bound = 2.04f * SCALE * sqrtf(q2 * P.kmax[bh]);
    const float* kb = P.kb + (size_t)bh * 4096;
    const float rel = SCALE * (kb[64 * lane + 63] - kb[P0]);
    const unsigned long long dead = __ballot(bound + rel < -106.0f);
    return __popcll(dead);
}
__device__ __forceinline__ Ref mkref(int w) {
    const int bh = w & 0xff, qb = (w >> 8) & 0xff, b = bh / 6, h = bh - 6 * b; Ref r;
    static_assert(QP == OP, "one offset serves q and o");
    r.qo = (b * 4096 + qb * QB) * QP + h * D; r.kv = b * 4096 * KVP + h * D; r.kb = bh * 4096; r.P0 = qb * QB + ((w >> 16) & 0xff); return r;
}
__device__ __forceinline__ void fox_phase(char* lds, const Tensors& T, const Plan& P, int vcu, int G, const int tid_in) {
    int* slot = (int*)(lds + LDS_BYTES);
    int nblk = 0;
    if (G == 256) {
        nblk = 3;
        if (tid_in < 192) { const int k = tid_in >> 6, lane = tid_in & 63, t = vcu & 15; unsigned wd = 0u; const unsigned tab[16] = {0x01090bu, 0x02061bu, 0x03080au, 0x04050fu, 0x13180du, 0x14161du, 0x00191fu, 0x24262bu, 0x10072du, 0x25150eu, 0x23280cu, 0x11291cu, 0x121a2cu, 0x202a1eu, 0x22172fu, 0x21272eu};
#pragma unroll
            for (int i = 0; i < 16; ++i) if (t == i) wd = tab[i];
            const unsigned e = (wd >> (8 * k)) & 0xffu; const int qb = e & 15, bh = 3 * (vcu >> 4) + (int)(e >> 4); const int jl = block_jlo(P, bh, qb, lane);
            if (lane == 0) slot[k] = bh | (qb << 8) | (jl << 16); }
    } else { for (int i = vcu; i < 768 && nblk < 16; i += G) { if (tid_in == 0) slot[nblk] = (i % 48) | ((15 - i / 48) << 8); ++nblk; } }
    __syncthreads();
    if (nblk == 0) return;
    Ref cur = mkref(__builtin_amdgcn_readfirstlane(slot[0]));
    Seam<bf16> S;
    causal_swa_prime<bf16, bf16>(T, cur, 4096, lds, S, tid_in);
    for (int k = 0; k < nblk; ++k) {
        const Ref nxt = k + 1 < nblk ? mkref(__builtin_amdgcn_readfirstlane(slot[k + 1])) : cur;
        causal_swa_block<bf16, bf16>(T, cur, nxt, 4096, 4096, lds, S, tid_in);
        cur = nxt;
    }
}
}
namespace gla {
typedef short bf16x8 __attribute__((ext_vector_type(8)));
typedef short s16x4 __attribute__((ext_vector_type(4)));
typedef float f32x16 __attribute__((ext_vector_type(16)));
constexpr int C = 64, DK = 96, DV = 192, NCH = SEQ / C, NUNIT = BATCH * GLA_H * NCH;
constexpr int RP = 208;
constexpr int L_GL = 0, L_WG = 4096, L_BG = 10240, L_CUM = 10752, L_TOT = 35328, L_Q = 36864, L_K = 50176, L_V = 63488, L_PS = 88064, L_RS = 89600, L_R = 89856, L_END = 89856 + 24576;
constexpr int L_Y = L_Q;
__device__ __forceinline__ int crow(int r, int hi) { return (r & 3) + 8 * (r >> 2) + 4 * hi; }
__device__ __forceinline__ float log_sigmoid_fast(float z) { return fminf(z, 0.f) - 0.6931471805599453f * __builtin_amdgcn_logf(1.0f + __builtin_amdgcn_exp2f(-1.4426950408889634f * fabsf(z))); }
__device__ __forceinline__ float exp_fast(float x) { return __builtin_amdgcn_exp2f(1.4426950408889634f * x); }
__device__ __forceinline__ unsigned cvtpk(float lo, float hi) { unsigned r; asm volatile("v_cvt_pk_bf16_f32 %0, %1, %2" : "=v"(r) : "v"(lo), "v"(hi)); return r; }
template <int NCB> __device__ __forceinline__ int tr_st(int k, int c) { const int kk = (k & ~0xC) | ((k & 4) << 1) | ((k & 8) >> 1); return ((kk >> 3) * NCB + (c >> 5)) * 512 + ((kk & 7) * 32 + (c & 31)) * 2; }
__device__ __forceinline__ int tr_rd_base(int lane) { return ((lane & 3) << 3) | (((lane >> 2) & 3) << 6) | (((lane >> 4) & 1) << 5) | (((lane >> 5) & 1) << 8); }
template <int NCB> constexpr int tr_rd_off(int cb, int ks, int half) { return cb * 512 + ks * (2 * NCB * 512) + half * (NCB * 512); }
#define GLA_TRRD(dst, addr, off) asm volatile("ds_read_b64_tr_b16 %0, %1 offset:%2" : "=&v"(dst) : "v"(addr), "i"(off) : "memory")
#define GLA_LWAIT() do { asm volatile("s_waitcnt lgkmcnt(0)" ::: "memory"); __builtin_amdgcn_sched_barrier(0); } while (0)
#define GLA_FRAG(l, h) ((bf16x8){l[0], l[1], l[2], l[3], h[0], h[1], h[2], h[3]})

struct Tens { const bf16* P; const float* wg; const float* bg; const float* ghead; bf16* DS; float* DEC; bf16* SP; bf16* MIX; float* CUM; };

__device__ __forceinline__ void gate_cum(const Tens& T, const v4u w, int h, bool newh, LAS unsigned char* lds, int tid) {
    LAS float* Gl = (LAS float*)(lds + L_GL); LAS float* Wg = (LAS float*)(lds + L_WG); LAS float* Bg = (LAS float*)(lds + L_BG); LAS float* Cum = (LAS float*)(lds + L_CUM); LAS float* Tot = (LAS float*)(lds + L_TOT);
    __syncthreads();
    if (tid < 128) { const int t = tid >> 1, c8 = tid & 1; LAS float* d = Gl + t * 16 + c8 * 8;
        d[0] = bf2f(w.x & 0xffff); d[1] = bf2f(w.x >> 16); d[2] = bf2f(w.y & 0xffff); d[3] = bf2f(w.y >> 16); d[4] = bf2f(w.z & 0xffff); d[5] = bf2f(w.z >> 16); d[6] = bf2f(w.w & 0xffff); d[7] = bf2f(w.w >> 16); }
    if (newh) { for (int idx = tid; idx < 16 * 96; idx += NTHR) Wg[idx] = T.wg[(idx / 96) * GLA_DK + h * 96 + idx % 96];
                if (tid < 96) Bg[tid] = T.bg[h * 96 + tid]; }
    __syncthreads();
    if (tid < 384) { const int seg = tid / 96, d = tid - seg * 96; float w[16];
#pragma unroll
        for (int r = 0; r < 16; ++r) w[r] = Wg[r * 96 + d];
        const float b0 = Bg[d]; float run = 0.f;
        for (int tt = 0; tt < 16; ++tt) { const int t = seg * 16 + tt; float z = b0;
#pragma unroll
            for (int r4 = 0; r4 < 4; ++r4) { const f32x4 g4 = *(const LAS f32x4*)(Gl + t * 16 + r4 * 4); z += g4.x * w[4 * r4] + g4.y * w[4 * r4 + 1] + g4.z * w[4 * r4 + 2] + g4.w * w[4 * r4 + 3]; }
            run += log_sigmoid_fast(z) * (1.0f / 16.0f); Cum[t * 96 + d] = run; }
        Tot[seg * 96 + d] = run; }
    __syncthreads();
    if (tid >= 96 && tid < 384) { const int seg = tid / 96, d = tid - seg * 96; float off = 0.f;
        for (int s = 0; s < seg; ++s) off += Tot[s * 96 + d];
        for (int tt = 0; tt < 16; ++tt) Cum[(seg * 16 + tt) * 96 + d] += off; }
    __syncthreads();
}
__device__ __forceinline__ void unpack8(const v4u w, float (&f)[8]) { f[0] = bf2f(w.x & 0xffff); f[1] = bf2f(w.x >> 16); f[2] = bf2f(w.y & 0xffff); f[3] = bf2f(w.y >> 16); f[4] = bf2f(w.z & 0xffff); f[5] = bf2f(w.z >> 16); f[6] = bf2f(w.w & 0xffff); f[7] = bf2f(w.w >> 16); }

#define GLA_LOADS_A(u_) do { const int bh_ = (u_) / NCH, c_ = (u_) - bh_ * NCH, h_ = bh_ & 3; const size_t r0_ = (size_t)(bh_ >> 2) * SEQ + c_ * C;                                      \
        const GAS unsigned char* pg_ = (const GAS unsigned char*)(T.P + r0_ * NA + PA_GL); const GAS unsigned char* pk_ = (const GAS unsigned char*)(T.P + r0_ * NA + PA_K + h_ * DK);   \
        const GAS unsigned char* pv_ = (const GAS unsigned char*)(T.P + r0_ * NA + PA_V + h_ * DV);                                    \
        if (tid < 128) rgl = *(const GAS v4u*)(pg_ + ogl);                                                                                                                                \
        rk[0] = *(const GAS v4u*)(pk_ + ok_[0]); if (tid < C * (DK / 8) - NTHR) rk[1] = *(const GAS v4u*)(pk_ + ok_[1]);                                                                  \
        _Pragma("unroll") for (int i = 0; i < 3; ++i) rv[i] = *(const GAS v4u*)(pv_ + ov_[i]); } while (0)
__device__ __forceinline__ void phase_a(const Tens& T, int u, const int G, LAS unsigned char* lds, int tid) {
    if (u >= NUNIT) return;
    const int lane = tid & 63, wave = __builtin_amdgcn_readfirstlane(tid >> 6);
    v4u rgl = {0u, 0u, 0u, 0u}, rk[2] = {{0u, 0u, 0u, 0u}, {0u, 0u, 0u, 0u}}, rv[3];
    unsigned ok_[2], ov_[3]; const unsigned ogl = (unsigned)((tid >> 1) * NA + (tid & 1) * 8) * 2u;
#pragma unroll
    for (int i = 0; i < 2; ++i) { const int idx = tid + i * NTHR, t = idx / 12, d8 = idx - t * 12; ok_[i] = (unsigned)(t * NA + d8 * 8) * 2u; }
#pragma unroll
    for (int i = 0; i < 3; ++i) { const int idx = tid + i * NTHR, t = idx / 24, e8 = idx - t * 24; ov_[i] = (unsigned)(t * NA + e8 * 8) * 2u; }
    GLA_LOADS_A(u);
    int hl = -1;
    for (;;) {
        const int bh = u / NCH, h = bh & 3, un = u + G;
        gate_cum(T, rgl, h, h != hl, lds, tid); hl = h;
        LAS float* Cum = (LAS float*)(lds + L_CUM);
#pragma unroll
        for (int i = 0; i < 2; ++i) { const int idx = tid + i * NTHR; if (idx >= C * (DK / 8)) break; const int t = idx / 12, d8 = idx - t * 12; float k[8];
            unpack8(rk[i], k);
            const f32x4 c0 = *(const LAS f32x4*)(Cum + t * 96 + d8 * 8), c1 = *(const LAS f32x4*)(Cum + t * 96 + d8 * 8 + 4), l0 = *(const LAS f32x4*)(Cum + 63 * 96 + d8 * 8), l1 = *(const LAS f32x4*)(Cum + 63 * 96 + d8 * 8 + 4);
            *(GAS f32x4*)(T.CUM + (size_t)u * (C * DK) + t * 96 + d8 * 8) = c0; *(GAS f32x4*)(T.CUM + (size_t)u * (C * DK) + t * 96 + d8 * 8 + 4) = c1;
            v4u o; o.x = cvtpk(k[0] * exp_fast(l0.x - c0.x), k[1] * exp_fast(l0.y - c0.y)); o.y = cvtpk(k[2] * exp_fast(l0.z - c0.z), k[3] * exp_fast(l0.w - c0.w));
            o.z = cvtpk(k[4] * exp_fast(l1.x - c1.x), k[5] * exp_fast(l1.y - c1.y)); o.w = cvtpk(k[6] * exp_fast(l1.z - c1.z), k[7] * exp_fast(l1.w - c1.w));
            *(LAS v4u*)(lds + L_K + tr_st<3>(t, d8 * 8)) = o; }
#pragma unroll
        for (int i = 0; i < 3; ++i) { const int idx = tid + i * NTHR, t = idx / 24, e8 = idx - t * 24; *(LAS v4u*)(lds + L_V + tr_st<6>(t, e8 * 8)) = rv[i]; }
        if (tid < 96) T.DEC[(size_t)u * DK + tid] = exp_fast(Cum[63 * 96 + tid]);
        __syncthreads();
        if (un < NUNIT) GLA_LOADS_A(un);
        if (wave < 6) {
            const int r32 = lane & 31, hi = lane >> 5, vb = L_V + tr_rd_base(lane), kb = L_K + tr_rd_base(lane);
            s16x4 vl[4], vh[4];
#define VRD(ks) do { GLA_TRRD(vl[ks], vb + wave * 512, tr_rd_off<6>(0, ks, 0)); GLA_TRRD(vh[ks], vb + wave * 512, tr_rd_off<6>(0, ks, 1)); } while (0)
            VRD(0); VRD(1); VRD(2); VRD(3);
#undef VRD
            bf16* out = T.DS + (size_t)u * (DV * DK) + (size_t)(wave * 32) * DK + r32;
#define DBLK(db) do { s16x4 kl[4], kh[4]; f32x16 acc = {};                                                                                     \
            GLA_TRRD(kl[0], kb, tr_rd_off<3>(db, 0, 0)); GLA_TRRD(kh[0], kb, tr_rd_off<3>(db, 0, 1)); GLA_TRRD(kl[1], kb, tr_rd_off<3>(db, 1, 0)); GLA_TRRD(kh[1], kb, tr_rd_off<3>(db, 1, 1)); \
            GLA_TRRD(kl[2], kb, tr_rd_off<3>(db, 2, 0)); GLA_TRRD(kh[2], kb, tr_rd_off<3>(db, 2, 1)); GLA_TRRD(kl[3], kb, tr_rd_off<3>(db, 3, 0)); GLA_TRRD(kh[3], kb, tr_rd_off<3>(db, 3, 1)); \
            GLA_LWAIT();                                                                                                                       \
            acc = __builtin_amdgcn_mfma_f32_32x32x16_bf16(GLA_FRAG(vl[0], vh[0]), GLA_FRAG(kl[0], kh[0]), acc, 0, 0, 0);                       \
            acc = __builtin_amdgcn_mfma_f32_32x32x16_bf16(GLA_FRAG(vl[1], vh[1]), GLA_FRAG(kl[1], kh[1]), acc, 0, 0, 0);                       \
            acc = __builtin_amdgcn_mfma_f32_32x32x16_bf16(GLA_FRAG(vl[2], vh[2]), GLA_FRAG(kl[2], kh[2]), acc, 0, 0, 0);                       \
            acc = __builtin_amdgcn_mfma_f32_32x32x16_bf16(GLA_FRAG(vl[3], vh[3]), GLA_FRAG(kl[3], kh[3]), acc, 0, 0, 0);                       \
            _Pragma("unroll") for (int r = 0; r < 16; ++r) { const float nb = __uint_as_float(__builtin_amdgcn_update_dpp(0u, __float_as_uint(acc[r]), 0xB1, 0xf, 0xf, false));     \
                if ((r32 & 1) == 0) *(unsigned*)(out + (size_t)crow(r, hi) * DK + (db) * 32) = cvtpk(acc[r], nb); } } while (0)
            DBLK(0); DBLK(1); DBLK(2);
#undef DBLK
        }
        if (un >= NUNIT) break;
        u = un;
    }
}
#undef GLA_LOADS_A
__device__ __forceinline__ void scan_phase(const Tens& T, int gtid, int nthreads) {
    for (int it = gtid; it < BATCH * GLA_H * DV * (DK / 4); it += nthreads) {
        const int bh = it / (DV * 24), rem = it - bh * (DV * 24), d4 = rem % 24;
        const size_t eoff = (size_t)rem * 4;
        f32x4 S = {0.f, 0.f, 0.f, 0.f};
        const bf16* ds = T.DS + (size_t)bh * NCH * (DV * DK) + eoff; const float* dc = T.DEC + (size_t)bh * NCH * DK + d4 * 4; bf16* sp = T.SP + (size_t)bh * NCH * (DV * DK) + eoff;
#pragma unroll 8
        for (int c = 0; c < NCH; ++c) {
            const unsigned long long dw = *(const GAS unsigned long long*)(ds + (size_t)c * (DV * DK)); const f32x4 a = *(const GAS f32x4*)(dc + c * DK);
            const f32x4 d = {bf2f((unsigned)dw & 0xffff), bf2f(((unsigned)dw) >> 16), bf2f((unsigned)(dw >> 32) & 0xffff), bf2f((unsigned)(dw >> 48))};
            unsigned long long w = (unsigned long long)cvtpk(S.x, S.y) | ((unsigned long long)cvtpk(S.z, S.w) << 32);
            *(GAS unsigned long long*)(sp + (size_t)c * (DV * DK)) = w;
            S = a * S + d; }
    }
}
#define GLA_LOADS_C(u_) do { const int bh_ = (u_) / NCH, c_ = (u_) - bh_ * NCH, h_ = bh_ & 3; const size_t r0_ = (size_t)(bh_ >> 2) * SEQ + c_ * C;                                      \
        const GAS unsigned char* pq_ = (const GAS unsigned char*)(T.P + r0_ * NA + PA_Q + h_ * DK); const GAS unsigned char* pv_ = (const GAS unsigned char*)(T.P + r0_ * NA + PA_V + h_ * DV);   \
        const GAS unsigned char* pc_ = (const GAS unsigned char*)(T.CUM + (size_t)(u_) * (C * DK));                                    \
        rq[0] = *(const GAS v4u*)(pq_ + ok_[0]); rk[0] = *(const GAS v4u*)(pq_ + (PA_K - PA_Q) * 2 + ok_[0]); rc[0][0] = *(const GAS f32x4*)(pc_ + oc_[0]); rc[0][1] = *(const GAS f32x4*)(pc_ + oc_[0] + 16);   \
        if (tid < C * (DK / 8) - NTHR) { rq[1] = *(const GAS v4u*)(pq_ + ok_[1]); rk[1] = *(const GAS v4u*)(pq_ + (PA_K - PA_Q) * 2 + ok_[1]); rc[1][0] = *(const GAS f32x4*)(pc_ + oc_[1]); rc[1][1] = *(const GAS f32x4*)(pc_ + oc_[1] + 16); }   \
        _Pragma("unroll") for (int i = 0; i < 3; ++i) { rv[i] = *(const GAS v4u*)(pv_ + ov_[i]); rr[i] = *(const GAS v4u*)(pv_ + (PA_R - PA_V) * 2 + ov_[i]); } } while (0)
#define GLA_LOADS_SF(u_) do { if (wave < 6) { const bf16* sp0 = T.SP + (size_t)(u_) * (DV * DK) + (size_t)(wave * 32 + (lane & 31)) * DK + 8 * (lane >> 5);                              \
            _Pragma("unroll") for (int ks = 0; ks < 6; ++ks) sf[ks] = *(const GAS bf16x8*)(sp0 + 16 * ks); } } while (0)
#define GLA_C_PREFETCH if (un < NUNIT) GLA_LOADS_C(un);
__device__ __forceinline__ void phase_c(const Tens& T, int u, const int G, LAS unsigned char* lds, int tid) {
    if (u >= NUNIT) return;
    const int lane = tid & 63, wave = __builtin_amdgcn_readfirstlane(tid >> 6);
    bf16x8 sf[6];
#pragma unroll
    for (int ks = 0; ks < 6; ++ks) sf[ks] = (bf16x8){0, 0, 0, 0, 0, 0, 0, 0};
    v4u rq[2] = {{0u, 0u, 0u, 0u}, {0u, 0u, 0u, 0u}}, rk[2] = {{0u, 0u, 0u, 0u}, {0u, 0u, 0u, 0u}}, rv[3], rr[3];
    f32x4 rc[2][2] = {{{0.f, 0.f, 0.f, 0.f}, {0.f, 0.f, 0.f, 0.f}}, {{0.f, 0.f, 0.f, 0.f}, {0.f, 0.f, 0.f, 0.f}}};
    unsigned ok_[2], oc_[2], ov_[3];
#pragma unroll
    for (int i = 0; i < 2; ++i) { const int idx = tid + i * NTHR, t = idx / 12, d8 = idx - t * 12; ok_[i] = (unsigned)(t * NA + d8 * 8) * 2u; oc_[i] = (unsigned)(t * 96 + d8 * 8) * 4u; }
#pragma unroll
    for (int i = 0; i < 3; ++i) { const int idx = tid + i * NTHR, t = idx / 24, e8 = idx - t * 24; ov_[i] = (unsigned)(t * NA + e8 * 8) * 2u; }
    GLA_LOADS_C(u);
    for (;;) {
        const int bh = u / NCH, c = u - bh * NCH, b = bh >> 2, h = bh & 3, un = u + G; const size_t row0 = (size_t)b * SEQ + c * C;
        __syncthreads();
        GLA_LOADS_SF(u);
#pragma unroll
        for (int i = 0; i < 2; ++i) { const int idx = tid + i * NTHR; if (idx >= C * (DK / 8)) break; const int t = idx / 12, d8 = idx - t * 12; float q[8], k[8];
            unpack8(rq[i], q); unpack8(rk[i], k);
            const f32x4 c0 = rc[i][0], c1 = rc[i][1];
            const float e0 = exp_fast(c0.x), e1 = exp_fast(c0.y), e2 = exp_fast(c0.z), e3 = exp_fast(c0.w), e4 = exp_fast(c1.x), e5 = exp_fast(c1.y), e6 = exp_fast(c1.z), e7 = exp_fast(c1.w);
            v4u o; o.x = cvtpk(q[0] * e0, q[1] * e1); o.y = cvtpk(q[2] * e2, q[3] * e3); o.z = cvtpk(q[4] * e4, q[5] * e5); o.w = cvtpk(q[6] * e6, q[7] * e7);
            *(LAS v4u*)(lds + L_Q + t * RP + d8 * 16) = o;
            v4u p; p.x = cvtpk(k[0] * __builtin_amdgcn_rcpf(e0), k[1] * __builtin_amdgcn_rcpf(e1)); p.y = cvtpk(k[2] * __builtin_amdgcn_rcpf(e2), k[3] * __builtin_amdgcn_rcpf(e3));
            p.z = cvtpk(k[4] * __builtin_amdgcn_rcpf(e4), k[5] * __builtin_amdgcn_rcpf(e5)); p.w = cvtpk(k[6] * __builtin_amdgcn_rcpf(e6), k[7] * __builtin_amdgcn_rcpf(e7));
            *(LAS v4u*)(lds + L_K + t * RP + d8 * 16) = p; }
#pragma unroll
        for (int i = 0; i < 3; ++i) { const int idx = tid + i * NTHR, t = idx / 24, e8 = idx - t * 24; *(LAS v4u*)(lds + L_V + tr_st<6>(t, e8 * 8)) = rv[i]; *(LAS v4u*)(lds + L_R + t * 384 + e8 * 16) = rr[i]; }
        __syncthreads();
        const int r32 = lane & 31, hi = lane >> 5;
        f32x16 o0 = {}, o1 = {};
        if (wave < 6) {
            f32x16 p00 = {}, p01 = {}, p11 = {};
            bf16x8 qf0[6], qf1[6];
    #pragma unroll
            for (int ks = 0; ks < 6; ++ks) { qf0[ks] = *(const LAS bf16x8*)(lds + L_Q + r32 * RP + (16 * ks + 8 * hi) * 2); qf1[ks] = *(const LAS bf16x8*)(lds + L_Q + (32 + r32) * RP + (16 * ks + 8 * hi) * 2); }
    #pragma unroll
            for (int ks = 0; ks < 6; ++ks) { const bf16x8 k0 = *(const LAS bf16x8*)(lds + L_K + r32 * RP + (16 * ks + 8 * hi) * 2), k1 = *(const LAS bf16x8*)(lds + L_K + (32 + r32) * RP + (16 * ks + 8 * hi) * 2);
                p00 = __builtin_amdgcn_mfma_f32_32x32x16_bf16(k0, qf0[ks], p00, 0, 0, 0);
                p01 = __builtin_amdgcn_mfma_f32_32x32x16_bf16(k0, qf1[ks], p01, 0, 0, 0);
                p11 = __builtin_amdgcn_mfma_f32_32x32x16_bf16(k1, qf1[ks], p11, 0, 0, 0); }
    #pragma unroll
            for (int r = 0; r < 16; ++r) { if (crow(r, hi) > r32) { p00[r] = 0.f; p11[r] = 0.f; } }
    #pragma unroll
            for (int ks = 0; ks < 6; ++ks) { o0 = __builtin_amdgcn_mfma_f32_32x32x16_bf16(qf0[ks], sf[ks], o0, 0, 0, 0); o1 = __builtin_amdgcn_mfma_f32_32x32x16_bf16(qf1[ks], sf[ks], o1, 0, 0, 0); }
            bf16x8 pa0, pa1, pb0, pb1, pb2, pb3;
    #define PK4(P, B_, OUT) do { unsigned a0 = cvtpk(P[B_+0], P[B_+1]), a1 = cvtpk(P[B_+2], P[B_+3]); unsigned b0 = cvtpk(P[B_+4], P[B_+5]), b1 = cvtpk(P[B_+6], P[B_+7]);          \
            auto r0 = __builtin_amdgcn_permlane32_swap(a0, b0, false, false); auto r1 = __builtin_amdgcn_permlane32_swap(a1, b1, false, false);                                    \
            u32x4 w = {r0[0], r1[0], r0[1], r1[1]}; OUT = *reinterpret_cast<bf16x8*>(&w); } while (0)
            typedef unsigned u32x4 __attribute__((ext_vector_type(4)));
            PK4(p00, 0, pa0); PK4(p00, 8, pa1); PK4(p01, 0, pb0); PK4(p01, 8, pb1); PK4(p11, 0, pb2); PK4(p11, 8, pb3);
    #undef PK4
            const int vb = L_V + tr_rd_base(lane) + wave * 512;
            s16x4 vl[4], vh[4];
            GLA_TRRD(vl[0], vb, tr_rd_off<6>(0, 0, 0)); GLA_TRRD(vh[0], vb, tr_rd_off<6>(0, 0, 1)); GLA_TRRD(vl[1], vb, tr_rd_off<6>(0, 1, 0)); GLA_TRRD(vh[1], vb, tr_rd_off<6>(0, 1, 1));
            GLA_TRRD(vl[2], vb, tr_rd_off<6>(0, 2, 0)); GLA_TRRD(vh[2], vb, tr_rd_off<6>(0, 2, 1)); GLA_TRRD(vl[3], vb, tr_rd_off<6>(0, 3, 0)); GLA_TRRD(vh[3], vb, tr_rd_off<6>(0, 3, 1));
            GLA_LWAIT();
            o0 = __builtin_amdgcn_mfma_f32_32x32x16_bf16(pa0, GLA_FRAG(vl[0], vh[0]), o0, 0, 0, 0); o0 = __builtin_amdgcn_mfma_f32_32x32x16_bf16(pa1, GLA_FRAG(vl[1], vh[1]), o0, 0, 0, 0);
            o1 = __builtin_amdgcn_mfma_f32_32x32x16_bf16(pb0, GLA_FRAG(vl[0], vh[0]), o1, 0, 0, 0); o1 = __builtin_amdgcn_mfma_f32_32x32x16_bf16(pb1, GLA_FRAG(vl[1], vh[1]), o1, 0, 0, 0);
            o1 = __builtin_amdgcn_mfma_f32_32x32x16_bf16(pb2, GLA_FRAG(vl[2], vh[2]), o1, 0, 0, 0); o1 = __builtin_amdgcn_mfma_f32_32x32x16_bf16(pb3, GLA_FRAG(vl[3], vh[3]), o1, 0, 0, 0);
        }
        GLA_C_PREFETCH
        if (wave < 6) {
            float v[32];
    #pragma unroll
            for (int r = 0; r < 16; ++r) { v[r] = o0[r] * o0[r]; v[16 + r] = o1[r] * o1[r]; }
    #define TRED(m, n) do { const bool up = (lane & (m)) != 0; _Pragma("unroll") for (int r = 0; r < (n); ++r) { const float send = up ? v[r] : v[r + (n)], keep = up ? v[r + (n)] : v[r]; v[r] = keep + __shfl_xor(send, (m)); } } while (0)
            TRED(16, 16); TRED(8, 8); TRED(4, 4); TRED(2, 2); TRED(1, 1);
    #undef TRED
            ((LAS float*)(lds + L_PS))[wave * 64 + 32 * (r32 >> 4) + crow(r32 & 15, hi)] = v[0];
        }
        __syncthreads();
        if (tid < 64) { LAS float* ps = (LAS float*)(lds + L_PS); const float s = ((ps[tid] + ps[64 + tid]) + (ps[128 + tid] + ps[192 + tid])) + (ps[256 + tid] + ps[320 + tid]);
            ((LAS float*)(lds + L_RS))[tid] = 1.0f / sqrtf(s * (1.0f / 192.0f) + EPS); }
        __syncthreads();
        if (wave < 6) {
            const LAS float* rs = (const LAS float*)(lds + L_RS) + 4 * hi; const int e = wave * 32 + r32; const float gh = T.ghead[e];
            const LAS bf16* rt = (const LAS bf16*)(lds + L_R) + 4 * hi * 192 + e; LAS bf16* yt = (LAS bf16*)(lds + L_Y) + 4 * hi * 192 + e;
    #pragma unroll
            for (int r = 0; r < 16; ++r) { const int ic = (r & 3) + 8 * (r >> 2);
                const float ra = bf2f(rt[ic * 192]), rb = bf2f(rt[(32 + ic) * 192]);
                const float ya = o0[r] * rs[ic] * gh * (ra * __builtin_amdgcn_rcpf(1.0f + exp_fast(-ra))), yb = o1[r] * rs[32 + ic] * gh * (rb * __builtin_amdgcn_rcpf(1.0f + exp_fast(-rb)));
                yt[ic * 192] = (bf16)f2bf(ya); yt[(32 + ic) * 192] = (bf16)f2bf(yb); }
        }
        __syncthreads();
        for (int idx = tid; idx < C * (DV / 8); idx += NTHR) { const int t = idx / 24, e8 = idx - t * 24;
            *(GAS v4u*)(T.MIX + (row0 + t) * DM + h * DV + e8 * 8) = *(const LAS v4u*)(lds + L_Y + t * 384 + e8 * 16); }

        if (un >= NUNIT) break;
        u = un;
    }
}
#undef GLA_C_PREFETCH
#undef GLA_LOADS_SF
#undef GLA_LOADS_C
}
namespace mema {
typedef short bf16x8 __attribute__((ext_vector_type(8)));
typedef short s16x4 __attribute__((ext_vector_type(4)));
typedef float f32x16 __attribute__((ext_vector_type(16)));
typedef unsigned u32x4 __attribute__((ext_vector_type(4)));
constexpr int L_K = 0, L_V = 32768, L_END = 65536;
#define MEM_KSWZ(row, colB) ((row) * 128 + ((colB) ^ (((row) & 7) << 4)))
struct Tens { const bf16* Q; int qpitch; const bf16* K; const bf16* V; bf16* O; };
__device__ __forceinline__ void stage_kv(const Tens& T, int b, int hh, LAS unsigned char* lds, int tid) {
    for (int idx = tid; idx < MEM_LEN * 8; idx += NTHR) { const int j = idx >> 3, c8 = idx & 7;
        const size_t g = (size_t)(b * MEM_LEN + j) * NMEMKV + hh * MEM_DH + c8 * 8;
        *(LAS v4u*)(lds + L_K + MEM_KSWZ(j, c8 * 16)) = *(const GAS v4u*)(T.K + g);
        *(LAS v4u*)(lds + L_V + gla::tr_st<2>(j, c8 * 8)) = *(const GAS v4u*)(T.V + g); }
}
__device__ __forceinline__ void unit(const Tens& T, int b, int hh, int qb, LAS unsigned char* lds, int tid) {
    const int lane = tid & 63, wave = __builtin_amdgcn_readfirstlane(tid >> 6), r32 = lane & 31, hi = lane >> 5;
    const size_t qrow = (size_t)b * SEQ + qb * 256 + wave * 32;
    bf16x8 qr[4];
#pragma unroll
    for (int ks = 0; ks < 4; ++ks) qr[ks] = *(const GAS bf16x8*)(T.Q + (qrow + r32) * T.qpitch + hh * MEM_DH + 16 * ks + 8 * hi);
    f32x16 p[8];
#pragma unroll
    for (int kb = 0; kb < 8; ++kb) { p[kb] = f32x16{};
#pragma unroll
        for (int ks = 0; ks < 4; ++ks) { const bf16x8 kf = *(const LAS bf16x8*)(lds + L_K + MEM_KSWZ(kb * 32 + r32, (16 * ks + 8 * hi) * 2));
            p[kb] = __builtin_amdgcn_mfma_f32_32x32x16_bf16(kf, qr[ks], p[kb], 0, 0, 0); } }
    float mx = p[0][0];
#pragma unroll
    for (int kb = 0; kb < 8; ++kb)
#pragma unroll
        for (int r = 0; r < 16; ++r) mx = fmaxf(mx, p[kb][r]);
    { auto rr = __builtin_amdgcn_permlane32_swap(__float_as_uint(mx), __float_as_uint(mx), false, false); mx = fmaxf(__uint_as_float(rr[0]), __uint_as_float(rr[1])); }
    const float mL = -mx * 1.4426950408889634f; float ps = 0.f;
#pragma unroll
    for (int kb = 0; kb < 8; ++kb)
#pragma unroll
        for (int r = 0; r < 16; ++r) { const float e = __builtin_amdgcn_exp2f(fmaf(p[kb][r], 1.4426950408889634f, mL)); p[kb][r] = e; ps += e; }
    { auto rr = __builtin_amdgcn_permlane32_swap(__float_as_uint(ps), __float_as_uint(ps), false, false); ps = __uint_as_float(rr[0]) + __uint_as_float(rr[1]); }
    f32x16 o0 = {}, o1 = {};
    const int vb = L_V + gla::tr_rd_base(lane);
#define MPK4(P, B_, OUT) do { unsigned a0 = gla::cvtpk(P[B_+0], P[B_+1]), a1 = gla::cvtpk(P[B_+2], P[B_+3]); unsigned b0 = gla::cvtpk(P[B_+4], P[B_+5]), b1 = gla::cvtpk(P[B_+6], P[B_+7]);   \
        auto r0 = __builtin_amdgcn_permlane32_swap(a0, b0, false, false); auto r1 = __builtin_amdgcn_permlane32_swap(a1, b1, false, false);                                           \
        u32x4 w = {r0[0], r1[0], r0[1], r1[1]}; OUT = *reinterpret_cast<bf16x8*>(&w); } while (0)
#define MPV(kb) do { bf16x8 pa0, pa1; MPK4(p[kb], 0, pa0); MPK4(p[kb], 8, pa1); s16x4 l0, h0, l1, h1, l2, h2, l3, h3;                                                                      \
        GLA_TRRD(l0, vb, gla::tr_rd_off<2>(0, 2 * (kb), 0)); GLA_TRRD(h0, vb, gla::tr_rd_off<2>(0, 2 * (kb), 1)); GLA_TRRD(l1, vb, gla::tr_rd_off<2>(0, 2 * (kb) + 1, 0)); GLA_TRRD(h1, vb, gla::tr_rd_off<2>(0, 2 * (kb) + 1, 1)); \
        GLA_TRRD(l2, vb, gla::tr_rd_off<2>(1, 2 * (kb), 0)); GLA_TRRD(h2, vb, gla::tr_rd_off<2>(1, 2 * (kb), 1)); GLA_TRRD(l3, vb, gla::tr_rd_off<2>(1, 2 * (kb) + 1, 0)); GLA_TRRD(h3, vb, gla::tr_rd_off<2>(1, 2 * (kb) + 1, 1)); \
        GLA_LWAIT();                                                                                                                                                                        \
        o0 = __builtin_amdgcn_mfma_f32_32x32x16_bf16(pa0, GLA_FRAG(l0, h0), o0, 0, 0, 0); o0 = __builtin_amdgcn_mfma_f32_32x32x16_bf16(pa1, GLA_FRAG(l1, h1), o0, 0, 0, 0);                \
        o1 = __builtin_amdgcn_mfma_f32_32x32x16_bf16(pa0, GLA_FRAG(l2, h2), o1, 0, 0, 0); o1 = __builtin_amdgcn_mfma_f32_32x32x16_bf16(pa1, GLA_FRAG(l3, h3), o1, 0, 0, 0); } while (0)
    MPV(0); MPV(1); MPV(2); MPV(3); MPV(4); MPV(5); MPV(6); MPV(7);
#undef MPV
#undef MPK4
    const float inv = 1.0f / ps;
    bf16* op = T.O + qrow * DM + hh * MEM_DH; const int lo = 4 * hi * DM + r32;
#pragma unroll
    for (int r = 0; r < 16; ++r) { const int ic = (r & 3) + 8 * (r >> 2); const float il = __shfl(inv, ic + 4 * hi);
        const float a = o0[r] * il, c = o1[r] * il; const float an = __shfl_xor(a, 1), cn = __shfl_xor(c, 1);
        if ((r32 & 1) == 0) { *(unsigned*)(op + (size_t)ic * DM + lo) = gla::cvtpk(a, an); *(unsigned*)(op + (size_t)ic * DM + lo + 32) = gla::cvtpk(c, cn); } }
}
#ifndef MEM_REP
#define MEM_REP 1
#endif
__device__ __forceinline__ void phase(const Tens& T, int vcu, int G, LAS unsigned char* lds, int tid) {
    int cur = -1;
    for (int u = vcu * 2; u < BATCH * MEM_H * 16; u += 2 * G)
        for (int k = 0; k < 2 * MEM_REP; ++k) { const int uu = u + (k & 1), bhh = uu >> 4, qb = uu & 15;
            if (bhh != cur) { __syncthreads(); stage_kv(T, bhh >> 2, bhh & 3, lds, tid); __syncthreads(); cur = bhh; }
            unit(T, bhh >> 2, bhh & 3, qb, lds, tid); }
    __syncthreads();
}
}
#ifndef PRO_REP_W
#define PRO_REP_W 1
#endif
#ifndef PRO_REP_X
#define PRO_REP_X 1
#endif
#ifndef NULL_EPI
#define NULL_EPI 0
#endif
#ifndef BAR_REP
#define BAR_REP 1
#endif
#ifndef REP_MASK
#define REP_MASK 0x0u
#endif
struct Args { const float* in[19]; float* out; unsigned char* ws; int ph_lo, ph_hi, onelaunch, pad; };
constexpr int I_W1 = (DM / 64) * (NFF1 / 64), I_W2 = (DFF / 64) * (DM / 64), I_WA = (DM / 64) * (NA / 64), I_WB = (DM / 64) * (NB / 64), I_WO = (DM / 64) * (DM / 64), I_WKV = (DM / 64) * (NKV / 64), I_WM1 = (DM / 64) * (512 / 64);
constexpr int STAT_ZERO_F4 = (NSTATS - 1) * M / 2;
constexpr int NITEMS = 8 * I_W1 + 8 * I_W2 + 2 * I_WA + 2 * I_WB + 4 * I_WO + I_WKV + 4 * I_WM1;

__device__ __forceinline__ int lane_now() { int l; asm volatile("v_mbcnt_lo_u32_b32 %0, -1, 0\n\tv_mbcnt_hi_u32_b32 %0, -1, %0" : "=v"(l)); return l; }
template <int OFF> __device__ __forceinline__ unsigned long long karg_u64() {
    unsigned long long v;
    asm volatile("s_load_dwordx2 %0, %1, %2\n\ts_waitcnt lgkmcnt(0)" : "=s"(v) : "s"(__builtin_amdgcn_kernarg_segment_ptr()), "i"(OFF) : "memory");
    return v;
}
#define IN_PTR(i) ((const float*)(const GAS float*)karg_u64<8 * (i)>())
#define OUT_PTR() ((float*)(GAS float*)karg_u64<8 * 19>())
#define WS_PTR() ((unsigned char*)(GAS unsigned char*)karg_u64<8 * 20>())
#define WSP(T, off) ((T*)(WS_PTR() + (off)))
#define STATP(i) (WSP(unsigned long long, WS_STATS) + (size_t)(i) * M)
#define MIXP() ((bf16*)OUT_PTR())
#define HALF_LAYER(l, hf) do { \
            if (hf == 1) { \
                PH_BEGIN(2) \
                    { const bool gla = l < 2; const int N = gla ? NA : NB; \
                      pg8::Gemm g{WSP(bf16, WS_HI), gla ? WSP(bf16, WS_WA) + (size_t)l * NA * DM : WSP(bf16, WS_WB) + (size_t)(l - 2) * NB * DM, M, N, DM}; pg8::StaticOrder S; S.init(M, N, GRID, BX); \
                      pg8::EpiBf16 E{WSP(bf16, WS_R2), N, STATP(1 + 3 * l), gla ? nullptr : WSP(float, WS_N2) + (size_t)(l - 2) * FOX_H * M, 3, M, gla ? A_IN_W : 0}; \
                      pg8::gemm_phase<pg8::EpiBf16, pg8::StaticOrder, true, true, DM>(lds + RING_OFF, g, S, E, TID); } \
                    if (l == 0 && (GRID < 192 || BX >= 128)) {     \
                      pg8::Gemm g{WSP(bf16, WS_MEMN), WSP(bf16, WS_WM), MEMROWS, NMEMKV, DM}; pg8::StaticOrder S; S.init(MEMROWS, NMEMKV, GRID, GRID < 192 ? BX : BX - 128); \
                      pg8::EpiBf16 E{WSP(bf16, WS_MEMKV), NMEMKV, nullptr, nullptr, 0, 0}; \
                      pg8::gemm_phase<pg8::EpiBf16, pg8::StaticOrder, true, true, DM>(lds + RING_OFF, g, S, E, TID); } \
                PH_END                                                       \
                if (l < 2) { \
                    PH_BEGIN(3) \
                        { const gla::Tens T{WSP(bf16, WS_R2), IN_PTR(10) + (size_t)l * GLA_R * GLA_DK, IN_PTR(11) + l * GLA_DK, IN_PTR(12) + l * GLA_DVH, WSP(bf16, WS_R1), WSP(float, WS_R1 + 144 * MiB), WSP(bf16, WS_R1), MIXP(), (float*)((unsigned char*)OUT_PTR() + 64 * MiB)}; \
                          gla::phase_a(T, VCU, GRID, lds, TID); } \
                        { const mema::Tens Tm{WSP(bf16, WS_R2) + PA_QM, NA, WSP(bf16, WS_MEMKV) + l * 512, WSP(bf16, WS_MEMKV) + l * 512 + 256, MIXP() + MAIN_W}; mema::phase(Tm, VCU, GRID, lds, TID); } \
                    PH_END \
                    PH_BEGIN(4) \
                        const gla::Tens T{WSP(bf16, WS_R2), nullptr, nullptr, nullptr, WSP(bf16, WS_R1), WSP(float, WS_R1 + 144 * MiB), WSP(bf16, WS_R1), MIXP(), (float*)((unsigned char*)OUT_PTR() + 64 * MiB)}; \
                        gla::scan_phase(T, VCU * NTHR + TID, GRID * NTHR); \
                    PH_END \
                    PH_BEGIN(15) \
                        const gla::Tens T{WSP(bf16, WS_R2), IN_PTR(10) + (size_t)l * GLA_R * GLA_DK, IN_PTR(11) + l * GLA_DK, IN_PTR(12) + l * GLA_DVH, WSP(bf16, WS_R1), WSP(float, WS_R1 + 144 * MiB), WSP(bf16, WS_R1), MIXP(), (float*)((unsigned char*)OUT_PTR() + 64 * MiB)}; \
                        gla::phase_c(T, VCU, GRID, lds, TID); \
                    PH_END \
                } else { \
                    PH_BEGIN(5) \
                        { const fox::Tensors T{WSP(bf16, WS_R2), WSP(bf16, WS_KV), MIXP(), WSP(float, WS_KBIAS)}; const fox::Plan Pl{WSP(float, WS_N2) + (size_t)(l - 2) * FOX_H * M, WSP(float, WS_KMAX), WSP(float, WS_KBIAS)}; fox::fox_phase((char*)lds, T, Pl, VCU, GRID, TID); } \
                        { const mema::Tens Tm{WSP(bf16, WS_R2) + MAIN_W, NB, WSP(bf16, WS_MEMKV) + l * 512, WSP(bf16, WS_MEMKV) + l * 512 + 256, MIXP() + MAIN_W}; mema::phase(Tm, VCU, GRID, lds, TID); } \
                    PH_END                                                   \
                } \
                PH_BEGIN(6) \
                    pg8::Gemm g{MIXP(), WSP(bf16, WS_WO) + (size_t)l * DM * DM, M, DM, DM}; pg8::StaticOrder S; S.init(M, DM, GRID, BX); \
                    pg8::EpiResidT24 E{rep_ ? MIXP() + (size_t)M * DM : WSP(bf16, WS_HI), rep_ ? WSP(unsigned char, WS_R1) : WSP(unsigned char, WS_LO), DM, 1.0f, rep_ ? nullptr : STATP(2 + 3 * l)}; \
                    pg8::gemm_phase<pg8::EpiResidT24, pg8::StaticOrder, false, true, DM>(lds + RING_OFF, g, S, E, TID); \
                PH_END_L(1)                                                  \
            } \
            PH_BEGIN(8) \
                if (l == 2 && hf == 0 && rep_ == 0) {     \
                    fgate_phase(WSP(bf16, WS_HI), WSP(unsigned char, WS_LO), IN_PTR(14), IN_PTR(16), IN_PTR(17), WSP(float, WS_SMALL), GW, NGW_, LANE); \
                    pg8::Gemm gk{WSP(bf16, WS_HI), WSP(bf16, WS_WKV), M, NKV, DM}; pg8::StaticOrder Sk; Sk.init(M, NKV, GRID, BX); \
                    pg8::EpiBf16 Ek{WSP(bf16, WS_KV), NKV, STATP(6), WSP(float, WS_N2) + (size_t)2 * FOX_H * M, 3, M}; \
                    pg8::gemm_phase<pg8::EpiBf16, pg8::StaticOrder, true, true, DM>(lds + RING_OFF, gk, Sk, Ek, TID); } \
                pg8::Gemm g{WSP(bf16, WS_HI), WSP(bf16, WS_W1) + (size_t)(l * 2 + hf) * NFF1 * DM, M, NFF1, DM}; pg8::StaticOrder S; S.init(M, NFF1, GRID, BX); \
                pg8::EpiSwiGLU E{WSP(bf16, WS_R1), DFF, STATP(hf == 0 ? 3 * l : 2 + 3 * l)}; \
                if (NULL_EPI && rep_) { pg8::EpiNull E0; pg8::gemm_phase<pg8::EpiNull, pg8::StaticOrder, true, true, DM>(lds + RING_OFF, g, S, E0, TID); } \
                else pg8::gemm_phase<pg8::EpiSwiGLU, pg8::StaticOrder, true, true, DM>(lds + RING_OFF, g, S, E, TID); \
            PH_END_L(!(l == 2 && hf == 0))                               \
            PH_BEGIN(9) \
                if (l == 2 && hf == 0 && rep_ == 0) dcum_phase(WSP(float, WS_SMALL), WSP(float, WS_SMALL + 1 * MiB), WSP(float, WS_KBIAS), WSP(float, WS_N2) + (size_t)2 * FOX_H * M, WSP(float, WS_KMAX), GW, NGW_, LANE);     \
                pg8::Gemm g{WSP(bf16, WS_R1), WSP(bf16, WS_W2) + (size_t)(l * 2 + hf) * DM * DFF, M, DM, DFF}; pg8::StaticOrder S; S.init(M, DM, GRID, BX); \
                pg8::EpiResidT24 E{rep_ ? MIXP() : WSP(bf16, WS_HI), rep_ ? (unsigned char*)(MIXP() + (size_t)M * DM) : WSP(unsigned char, WS_LO), DM, 0.5f, rep_ ? nullptr : (hf == 0 ? STATP(1 + 3 * l) : (l < DEPTH - 1 ? STATP(3 + 3 * l) : nullptr))}; \
                if (NULL_EPI && rep_) { pg8::EpiNull E0; pg8::gemm_phase<pg8::EpiNull, pg8::StaticOrder, true, true, DFF>(lds + RING_OFF, g, S, E0, TID); } \
                else pg8::gemm_phase<pg8::EpiResidT24, pg8::StaticOrder, false, true, DFF>(lds + RING_OFF, g, S, E, TID); \
            PH_END_L(hf == 0 || l == 0 || l == 2)                        \
            if (hf == 1 && l == DEPTH - 1) { \
                PH_BEGIN(13) \
                    const RowArgs a{nullptr, WSP(bf16, WS_HI), WSP(unsigned char, WS_LO), IN_PTR(18), nullptr, nullptr, nullptr, nullptr, OUT_PTR(), nullptr, nullptr, nullptr, M}; row_phase(a, GW, NGW_, LANE); \
                PH_END \
            } \
    } while (0)
__global__ void __launch_bounds__(NTHR, 2) yoco_fwd(Args args) {
    extern __shared__ __attribute__((aligned(16))) unsigned char lds_raw[];
    LAS unsigned char* const lds0 = (LAS unsigned char*)lds_raw;
    const int wave_s = __builtin_amdgcn_readfirstlane((int)(threadIdx.x >> 6));
    { const int t0 = wave_s * 64 + lane_now();
      for (int u = t0; u < (LDS_BYTES - LDSCTL_OFF) / 4; u += NTHR) ((LAS unsigned*)(lds0 + LDSCTL_OFF))[u] = 0u;
      __syncthreads();
      if (args.onelaunch) { (void)xcd_barrier_post((unsigned*)(WSP(unsigned, WS_CTL) + CW_BAR), (volatile LAS unsigned*)(lds0 + MISC_OFF) + 8, t0); xcd_local_post((unsigned*)(WSP(unsigned, WS_CTL) + CW_BAR), t0, (int)blockIdx.x); } }
#define TID tid_
#define LANE (tid_ & 63)
#define WAVE (__builtin_amdgcn_readfirstlane(tid_ >> 6))
#define GRID ((int)gridDim.x)
#define BX bx_
#define VCU ((GRID % 8 == 0) ? (BX % 8) * (GRID / 8) + BX / 8 : BX)
#define GW (VCU * NWAVES + WAVE)
#define NGW_ (GRID * NWAVES)
    const int lo = args.ph_lo, hi = args.ph_hi;
    int ph = 0;
#define PH_BEGIN(site) if (ph >= lo && ph < hi) { int tid_ = wave_s * 64 + lane_now(); asm volatile("" : "+v"(tid_)); int bx_ = blockIdx.x; asm volatile("" : "+s"(bx_)); LAS unsigned char* lds = lds0; asm volatile("" : "+s"(lds));     \
    for (int rep_ = 0; rep_ <= (int)((REP_MASK >> (site)) & 1u); ++rep_) {
#define PH_END_L(loc) } if (ph + 1 < hi) { XcdBarrier bar_; bar_.bar = (unsigned*)(WSP(unsigned, WS_CTL) + CW_BAR); bar_.x = xb_xcc_id(); bar_.st = (volatile LAS unsigned*)(lds + MISC_OFF) + 8; if ((loc) && args.onelaunch) xcd_seam(bar_, tid_, bx_, GRID); else xcd_barrier(bar_, tid_); } } ++ph;
#define PH_END   } if (ph + 1 < hi) { XcdBarrier bar_; bar_.bar = (unsigned*)(WSP(unsigned, WS_CTL) + CW_BAR); bar_.x = xb_xcc_id(); bar_.st = (volatile LAS unsigned*)(lds + MISC_OFF) + 8; xcd_barrier(bar_, tid_); if (BAR_REP > 1) xcd_barrier(bar_, tid_); } } ++ph;

    PH_BEGIN(0)
        LAS float* scr = (LAS float*)(lds + RING_OFF + WAVE * 16384);
        for (int it = GW; it < NITEMS * PRO_REP_W; it += NGW_) {
            int r = it % NITEMS;
            if (r < 8 * I_W1) { const int mat = r / I_W1; transpose_item(IN_PTR(3) + (size_t)mat * DM * NFF1, DM, NFF1, NFF1, WSP(bf16, WS_W1) + (size_t)mat * NFF1 * DM, scr, r % I_W1, LANE, IN_PTR(2) + (size_t)mat * DM, MapSwi()); continue; } r -= 8 * I_W1;
            if (r < 8 * I_W2) { const int mat = r / I_W2; transpose_item(IN_PTR(4) + (size_t)mat * DFF * DM, DFF, DM, DM, WSP(bf16, WS_W2) + (size_t)mat * DM * DFF, scr, r % I_W2, LANE, nullptr, MapResid()); continue; } r -= 8 * I_W2;
            if (r < 2 * I_WA) { const int mat = r / I_WA; transpose_item(IN_PTR(9) + (size_t)mat * DM * A_IN_W, DM, A_IN_W, NA, WSP(bf16, WS_WA) + (size_t)mat * NA * DM, scr, r % I_WA, LANE, IN_PTR(5) + (size_t)mat * DM, MapInA()); continue; } r -= 2 * I_WA;
            if (r < 2 * I_WB) { const int mat = r / I_WB; transpose_item(IN_PTR(13) + (size_t)mat * DM * NB, DM, NB, NB, WSP(bf16, WS_WB) + (size_t)mat * NB * DM, scr, r % I_WB, LANE, IN_PTR(5) + (size_t)(2 + mat) * DM, MapInB()); continue; } r -= 2 * I_WB;
            if (r < 4 * I_WO) { const int mat = r / I_WO; transpose_item(IN_PTR(8) + (size_t)mat * DM * DM, DM, DM, DM, WSP(bf16, WS_WO) + (size_t)mat * DM * DM, scr, r % I_WO, LANE, nullptr, MapResid()); continue; } r -= 4 * I_WO;
            if (r < I_WKV) { transpose_item(IN_PTR(15), DM, NKV, NKV, WSP(bf16, WS_WKV), scr, r, LANE, IN_PTR(14), MapPlain()); continue; } r -= I_WKV;
            { const int mat = r / I_WM1; transpose_item(IN_PTR(7) + (size_t)mat * DM * 512, DM, 512, 512, WSP(bf16, WS_WM) + (size_t)mat * 512 * DM, scr, r % I_WM1, LANE, IN_PTR(6) + mat * DM, MapPlain()); }
        }
        { GAS f32x4* z = (GAS f32x4*)STATP(1); for (int i = VCU * NTHR + TID; i < STAT_ZERO_F4; i += GRID * NTHR) z[i] = (f32x4){0.f, 0.f, 0.f, 0.f}; }
        { GAS f32x4* z = (GAS f32x4*)WSP(float, WS_N2); for (int i = VCU * NTHR + TID; i < 3 * FOX_H * M / 4; i += GRID * NTHR) z[i] = (f32x4){0.f, 0.f, 0.f, 0.f}; }
        { const RowArgs a{IN_PTR(1), nullptr, nullptr, nullptr, nullptr, nullptr, nullptr, WSP(bf16, WS_MEMN), nullptr, nullptr, nullptr, nullptr, MEMROWS}; row_phase(a, GW, NGW_, LANE); }
        for (int xr_ = 0; xr_ < PRO_REP_X; ++xr_) { const RowArgs a{IN_PTR(0), nullptr, nullptr, nullptr, WSP(bf16, WS_HI), WSP(unsigned char, WS_LO), STATP(0), nullptr, nullptr, nullptr, nullptr, nullptr, M}; row_phase(a, GW, NGW_, LANE); }
    PH_END

    HALF_LAYER(0, 0); HALF_LAYER(0, 1); HALF_LAYER(1, 0); HALF_LAYER(1, 1); HALF_LAYER(2, 0); HALF_LAYER(2, 1); HALF_LAYER(3, 0); HALF_LAYER(3, 1);
#undef HALF_LAYER
#undef PH_BEGIN
#undef PH_END
}

static int count_phases() { int n = 2; for (int l = 0; l < DEPTH; ++l) n += 7 + (l < 2 ? 2 : 0); return n; }
#ifndef ONE_LAUNCH
#define ONE_LAUNCH 1
#endif
extern "C" void kernel_launch(void* const* d_in, const int* in_sizes, int n_in, void* d_out, int out_size, void* d_ws, size_t ws_size, hipStream_t stream) {
    static int grid = 0;
    if (grid == 0) {
        if (n_in != 19 || in_sizes[0] != M * DM || out_size != M * DM || ws_size < WS_END) { fprintf(stderr, "kernel_launch: unexpected shapes (n_in %d, in0 %d, out %d, ws %zu < %zu); nothing launched\n", n_in, n_in > 0 ? in_sizes[0] : -1, out_size, ws_size, (size_t)WS_END); grid = -1; return; }
        int dev = 0, cus = 0, per_cu = 0;
        if (hipGetDevice(&dev) != hipSuccess || hipDeviceGetAttribute(&cus, hipDeviceAttributeMultiprocessorCount, dev) != hipSuccess) { grid = -1; return; }
        if (hipFuncSetAttribute((const void*)yoco_fwd, hipFuncAttributeMaxDynamicSharedMemorySize, LDS_BYTES) != hipSuccess) { fprintf(stderr, "kernel_launch: hipFuncSetAttribute failed\n"); grid = -1; return; }
        if (hipOccupancyMaxActiveBlocksPerMultiprocessor(&per_cu, (const void*)yoco_fwd, NTHR, LDS_BYTES) != hipSuccess || per_cu < 1) fprintf(stderr, "kernel_launch: occupancy query reports %d\n", per_cu);
        (void)hipGetLastError();
        grid = cus;
    }
    if (grid < 0) return;
    if (hipMemsetAsync((char*)d_ws + WS_CTL, 0, CTL_ZERO_BYTES, stream) != hipSuccess) return;
    Args a{};
    for (int i = 0; i < 19; ++i) a.in[i] = (const float*)d_in[i];
    a.out = (float*)d_out; a.ws = (unsigned char*)d_ws; a.pad = 0;
    const int nph = count_phases();
    if (ONE_LAUNCH) { a.ph_lo = 0; a.ph_hi = nph; a.onelaunch = 1; hipLaunchKernelGGL(yoco_fwd, dim3(grid), dim3(NTHR), LDS_BYTES, stream, a); }
    else for (int p = 0; p < nph; ++p) { a.ph_lo = p; a.ph_hi = p + 1; a.onelaunch = 0; hipLaunchKernelGGL(yoco_fwd, dim3(grid), dim3(NTHR), LDS_BYTES, stream, a); }
}
```
